# Optimizing an MI355X kernel written in HIP

```python
import math
import jax
import jax.numpy as jnp
from jax import lax
import numpy as np

D_MODEL = 2048
BATCH = 4
SEQ = 2048
DEPTH = 4
DEC_BATCH = 8
DEC_SEQ = 64
PAST_LEN = 4096

CHUNK = 64
Q_BLOCK = 128
N_MIXERS = 3
NA_LAYERS = (DEPTH + 2) // 3
NB_LAYERS = (DEPTH + 1) // 3
NC_LAYERS = DEPTH // 3
D_MIX = D_MODEL
ROPE_THETA = 10000.0
RMS_EPS = 1e-6
DH_A = 64
H_A = D_MIX // (2 * DH_A)
SUBLN_EPS = 1e-5
HD_B = 128
H_B = D_MIX // HD_B
KV_B = 4
H_IDX = 16
D_IDX = 64
TOPK_MAX = 256
B_SIZES = (H_B * HD_B, KV_B * HD_B, KV_B * HD_B, H_IDX * D_IDX, D_IDX, H_IDX, D_MIX)
B_IN = sum(B_SIZES)
HS_C = 64
H_C = D_MIX // HS_C
R_DECAY = 96
R_ICLR = 96
GN_EPS = 64e-5

kernel_name = 'hybrid_chunk_stream_diffattn_dsa_rwkv7'


def _rmsnorm(x, g, eps=RMS_EPS):
    xf = x.astype(jnp.float32)
    y = xf * lax.rsqrt(jnp.mean(xf * xf, axis=-1, keepdims=True) + eps)
    return (y * g.astype(jnp.float32)).astype(x.dtype)


def _rope(x, pos):
    dh = x.shape[-1]
    half = dh // 2
    inv = jnp.power(ROPE_THETA, -jnp.arange(half, dtype=jnp.float32) * (2.0 / dh))
    ang = pos.astype(jnp.float32)[:, None] * inv[None, :]
    shape = (ang.shape[0],) + (1,) * (x.ndim - 3) + (half,)
    cos = jnp.cos(ang).reshape(shape)
    sin = jnp.sin(ang).reshape(shape)
    xf = x.astype(jnp.float32)
    x1, x2 = xf[..., :half], xf[..., half:]
    return jnp.concatenate([x1 * cos - x2 * sin, x2 * cos + x1 * sin], axis=-1).astype(x.dtype)


def _over_query_blocks(fn, *qs):
    t = qs[0].shape[1]
    if t <= Q_BLOCK or t % Q_BLOCK:
        return fn(*qs)
    nb = t // Q_BLOCK
    blocks = tuple(jnp.moveaxis(a.reshape((a.shape[0], nb, Q_BLOCK) + a.shape[2:]), 1, 0) for a in qs)
    out = lax.map(lambda args: fn(*args), blocks)
    out = jnp.moveaxis(out, 0, 1)
    return out.reshape((out.shape[0], t) + out.shape[3:])


def _diff_attn(h, pos, k_past, v_past, w_in, lam_p, subln_g, lam_init):
    b, t, _ = h.shape
    q, k, v, g = jnp.split(h @ w_in, 4, axis=-1)
    q = _rope(q.reshape(b, t, H_A, 2, DH_A), pos)
    k = _rope(k.reshape(b, t, H_A, 2, DH_A), pos)
    k_rows = k.reshape(b, t, H_A, 2 * DH_A)
    v_rows = v.reshape(b, t, H_A, 2 * DH_A)
    if k_past is None:
        k_all, v_all = k_rows, v_rows
    else:
        k_all = jnp.concatenate([k_past.astype(k_rows.dtype), k_rows], axis=1)
        v_all = jnp.concatenate([v_past.astype(v_rows.dtype), v_rows], axis=1)
    s = k_all.shape[1]
    kpos = jnp.arange(s)
    k_all = k_all.reshape(b, s, H_A, 2, DH_A)
    k1, k2 = k_all[..., 0, :], k_all[..., 1, :]
    lp = lam_p.astype(jnp.float32)
    lam = jnp.exp(jnp.sum(lp[0] * lp[1])) - jnp.exp(jnp.sum(lp[2] * lp[3])) + lam_init

    def core(q1, q2, qp):
        mask = (kpos // CHUNK)[None, :] <= (qp[0] // CHUNK)[:, None]
        def attn_map(qq, kk):
            sc = jnp.einsum('bqhd,bkhd->bhqk', qq.astype(jnp.float32), kk.astype(jnp.float32)) * DH_A ** -0.5
            return jax.nn.softmax(jnp.where(mask, sc, -jnp.inf), axis=-1)
        p = attn_map(q1, k1) - lam * attn_map(q2, k2)
        return jnp.einsum('bhqk,bkhe->bqhe', p, v_all.astype(jnp.float32))

    o = _over_query_blocks(core, q[..., 0, :], q[..., 1, :], pos[None])
    o = o * lax.rsqrt(jnp.mean(o * o, axis=-1, keepdims=True) + SUBLN_EPS) * subln_g.astype(jnp.float32)
    o = (o * (1.0 - lam_init)).reshape(b, t, D_MIX)
    return (o * jax.nn.silu(g.astype(jnp.float32))).astype(h.dtype), k_rows, v_rows


def _dsa_attn(h, pos, k_past, v_past, ki_past, w_in):
    b, t, _ = h.shape
    offs = np.cumsum(B_SIZES)[:-1].tolist()
    q, k, v, qi, ki, wi, g = jnp.split(h @ w_in, offs, axis=-1)
    q = _rope(q.reshape(b, t, H_B, HD_B), pos)
    k_rows = _rope(k.reshape(b, t, KV_B, HD_B), pos)
    v_rows = v.reshape(b, t, KV_B, HD_B)
    qi = _rope(qi.reshape(b, t, H_IDX, D_IDX), pos)
    ki_rows = _rope(ki, pos)
    wi = wi * H_IDX ** -0.5
    if k_past is None:
        k_all, v_all, ki_all = k_rows, v_rows, ki_rows
    else:
        k_all = jnp.concatenate([k_past.astype(k_rows.dtype), k_rows], axis=1)
        v_all = jnp.concatenate([v_past.astype(v_rows.dtype), v_rows], axis=1)
        ki_all = jnp.concatenate([ki_past.astype(ki_rows.dtype), ki_rows], axis=1)
    s = k_all.shape[1]
    kpos = jnp.arange(s)
    n_sel = min(TOPK_MAX, s // 4)
    take = jax.vmap(lambda rows, ix: rows[ix])

    def core(q_, qi_, wi_, qp):
        qp = qp[0]
        tq = q_.shape[1]
        adm = (kpos // CHUNK)[None, :] <= (qp // CHUNK)[:, None]
        logits = jnp.einsum('bqhd,bsd->bqhs', qi_.astype(jnp.float32), ki_all.astype(jnp.float32)) * D_IDX ** -0.5
        score = jnp.einsum('bqh,bqhs->bqs', wi_.astype(jnp.float32), jax.nn.relu(logits))
        score = jnp.where(adm[None], score, -jnp.inf)
        _, idx = lax.top_k(score, n_sel)
        valid = (idx // CHUNK) <= (qp // CHUNK)[None, :, None]
        kg = take(k_all, idx).astype(jnp.float32)
        vg = take(v_all, idx).astype(jnp.float32)
        qg = q_.astype(jnp.float32).reshape(b, tq, KV_B, H_B // KV_B, HD_B)
        sc = jnp.einsum('bqgrd,bqngd->bqgrn', qg, kg) * HD_B ** -0.5
        p = jax.nn.softmax(jnp.where(valid[:, :, None, None, :], sc, -jnp.inf), axis=-1)
        return jnp.einsum('bqgrn,bqngd->bqgrd', p, vg).reshape(b, tq, D_MIX)

    o = _over_query_blocks(core, q, qi, wi, pos[None])
    return (o * jax.nn.silu(g.astype(jnp.float32))).astype(h.dtype), k_rows, v_rows, ki_rows


def _rwkv_scan(r, w, k, v, kk, a, s0):
    def step(st, inp):
        r_t, w_t, k_t, v_t, kk_t, a_t = inp
        sa = jnp.einsum('bhvk,bhk->bhv', st, -kk_t)
        st = st * w_t[:, :, None, :] + sa[..., None] * (kk_t * a_t)[:, :, None, :] + v_t[..., None] * k_t[:, :, None, :]
        return st, jnp.einsum('bhvk,bhk->bhv', st, r_t)
    xs = tuple(jnp.moveaxis(u, 1, 0) for u in (r, w, k, v, kk, a))
    s_new, o = lax.scan(step, s0, xs)
    return jnp.moveaxis(o, 0, 1), s_new


def _rwkv_mix(h, shift0, s0, mu, w_rkvg, w0, w_la, w_lb, a0, a_la, a_lb, k_k, k_a, r_k, ln_w, ln_b):
    b, t, d = h.shape
    hf = h.astype(jnp.float32)
    prev = jnp.concatenate([shift0.astype(jnp.float32)[:, None], hf[:, :-1]], axis=1)
    lerp = hf[None] + (prev - hf)[None] * mu.astype(jnp.float32)[:, None, None, :]
    r, k, v, g = jnp.einsum('nbtd,nde->nbte', lerp[:4], w_rkvg.astype(jnp.float32))
    w_log = -jax.nn.softplus(-(w0 + jnp.tanh(lerp[4] @ w_la) @ w_lb)) - 0.5
    decay = jnp.exp(-jnp.exp(w_log))
    a = jax.nn.sigmoid(a0 + (lerp[5] @ a_la) @ a_lb)
    heads = lambda u: u.reshape(b, t, H_C, HS_C)
    kk = heads(k * k_k)
    kk = kk / jnp.maximum(jnp.sqrt(jnp.sum(kk * kk, axis=-1, keepdims=True)), 1e-12)
    k = k * (1.0 + (a - 1.0) * k_a)
    r_h, k_h, v_h, w_h, a_h = heads(r), heads(k), heads(v), heads(decay), heads(a)
    o, s_new = _rwkv_scan(r_h, w_h, k_h, v_h, kk, a_h, s0.astype(jnp.float32))
    mean = jnp.mean(o, axis=-1, keepdims=True)
    var = jnp.mean(jnp.square(o - mean), axis=-1, keepdims=True)
    o = ((o - mean) * lax.rsqrt(var + GN_EPS)).reshape(b, t, d) * ln_w + ln_b
    bonus = jnp.sum(r_h * k_h * r_k, axis=-1, keepdims=True) * v_h
    o = o + bonus.reshape(b, t, d)
    return (o * jax.nn.silu(g)).astype(h.dtype), s_new, h[:, -1]


def setup_inputs(seed: int = 0) -> dict:
    key = jax.random.key(seed)
    ks = iter(jax.random.split(key, 40))
    f32 = jnp.float32
    d = D_MODEL
    nrm = lambda shape, scale: jax.random.normal(next(ks), shape, f32) * scale
    return {
        'x_prompt': nrm((BATCH, SEQ, d), 1.0),
        'x_sample': nrm((DEC_BATCH, DEC_SEQ, d), 1.0),
        'cache_a_k': nrm((NA_LAYERS, DEC_BATCH, PAST_LEN, H_A, 2 * DH_A), 1.0),
        'cache_a_v': nrm((NA_LAYERS, DEC_BATCH, PAST_LEN, H_A, 2 * DH_A), 1.0),
        'cache_b_k': nrm((NB_LAYERS, DEC_BATCH, PAST_LEN, KV_B, HD_B), 1.0),
        'cache_b_v': nrm((NB_LAYERS, DEC_BATCH, PAST_LEN, KV_B, HD_B), 1.0),
        'cache_b_kidx': nrm((NB_LAYERS, DEC_BATCH, PAST_LEN, D_IDX), 1.0),
        'state_c_wkv': nrm((NC_LAYERS, DEC_BATCH, H_C, HS_C, HS_C), 0.3),
        'state_c_shift': nrm((NC_LAYERS, DEC_BATCH, d), 1.0),
        'norm_g': 1.0 + nrm((DEPTH, d), 0.02),
        'final_g': 1.0 + nrm((d,), 0.02),
        'w_out': nrm((DEPTH, D_MIX, d), D_MIX ** -0.5),
        'a_w_in': nrm((NA_LAYERS, d, 4 * D_MIX), d ** -0.5),
        'a_lam': nrm((NA_LAYERS, 4, DH_A), 0.1),
        'a_subln_g': 1.0 + nrm((NA_LAYERS, 2 * DH_A), 0.02),
        'b_w_in': nrm((NB_LAYERS, d, B_IN), d ** -0.5),
        'c_mu': jax.random.uniform(next(ks), (NC_LAYERS, 6, d), f32),
        'c_w_rkvg': nrm((NC_LAYERS, 4, d, D_MIX), d ** -0.5),
        'c_w0': -1.0 + nrm((NC_LAYERS, D_MIX), 0.3),
        'c_w_la': nrm((NC_LAYERS, d, R_DECAY), d ** -0.5),
        'c_w_lb': nrm((NC_LAYERS, R_DECAY, D_MIX), 0.1 * R_DECAY ** -0.5),
        'c_a0': nrm((NC_LAYERS, D_MIX), 0.1),
        'c_a_la': nrm((NC_LAYERS, d, R_ICLR), d ** -0.5),
        'c_a_lb': nrm((NC_LAYERS, R_ICLR, D_MIX), 0.1 * R_ICLR ** -0.5),
        'c_k_k': 0.85 + nrm((NC_LAYERS, D_MIX), 0.02),
        'c_k_a': 1.0 + nrm((NC_LAYERS, D_MIX), 0.02),
        'c_r_k': nrm((NC_LAYERS, H_C, HS_C), 0.1),
        'c_ln_w': 1.0 + nrm((NC_LAYERS, D_MIX), 0.02),
        'c_ln_b': nrm((NC_LAYERS, D_MIX), 0.02),
    }


def reference(x_prompt, x_sample, cache_a_k, cache_a_v, cache_b_k, cache_b_v, cache_b_kidx, state_c_wkv, state_c_shift, norm_g, final_g, w_out, a_w_in, a_lam, a_subln_g, b_w_in, c_mu, c_w_rkvg, c_w0, c_w_la, c_w_lb, c_a0, c_a_la, c_a_lb, c_k_k, c_k_a, c_r_k, c_ln_w, c_ln_b):
    n_prompt = x_prompt.shape[1]
    past = cache_a_k.shape[2]
    n_new = x_sample.shape[1]
    pos_p = jnp.arange(n_prompt)
    pos_s = past + jnp.arange(n_new)
    xp, xs = x_prompt, x_sample
    a_kp, a_vp, a_ks, a_vs = [], [], [], []
    b_kp, b_vp, b_ip, b_ks, b_vs, b_is = [], [], [], [], [], []
    c_wp, c_hp, c_ws, c_hs = [], [], [], []
    for i in range(DEPTH):
        kind, j = i % N_MIXERS, i // N_MIXERS
        hp = _rmsnorm(xp, norm_g[i])
        hs = _rmsnorm(xs, norm_g[i])
        if kind == 0:
            lam_init = 0.8 - 0.6 * math.exp(-0.3 * i)
            op, kr, vr = _diff_attn(hp, pos_p, None, None, a_w_in[j], a_lam[j], a_subln_g[j], lam_init)
            a_kp.append(kr)
            a_vp.append(vr)
            os_, kr, vr = _diff_attn(hs, pos_s, cache_a_k[j], cache_a_v[j], a_w_in[j], a_lam[j], a_subln_g[j], lam_init)
            a_ks.append(kr)
            a_vs.append(vr)
        elif kind == 1:
            op, kr, vr, ir = _dsa_attn(hp, pos_p, None, None, None, b_w_in[j])
            b_kp.append(kr)
            b_vp.append(vr)
            b_ip.append(ir)
            os_, kr, vr, ir = _dsa_attn(hs, pos_s, cache_b_k[j], cache_b_v[j], cache_b_kidx[j], b_w_in[j])
            b_ks.append(kr)
            b_vs.append(vr)
            b_is.append(ir)
        else:
            cp = (c_mu[j], c_w_rkvg[j], c_w0[j], c_w_la[j], c_w_lb[j], c_a0[j], c_a_la[j], c_a_lb[j], c_k_k[j], c_k_a[j], c_r_k[j], c_ln_w[j], c_ln_b[j])
            bp = xp.shape[0]
            op, sw, sh = _rwkv_mix(hp, jnp.zeros((bp, D_MODEL), hp.dtype), jnp.zeros((bp, H_C, HS_C, HS_C), jnp.float32), *cp)
            c_wp.append(sw)
            c_hp.append(sh)
            os_, sw, sh = _rwkv_mix(hs, state_c_shift[j], state_c_wkv[j], *cp)
            c_ws.append(sw)
            c_hs.append(sh)
        xp = xp + op @ w_out[i]
        xs = xs + os_ @ w_out[i]
    y_prompt = _rmsnorm(xp, final_g)
    y_sample = _rmsnorm(xs, final_g)
    return (y_prompt, y_sample,
            jnp.stack(a_kp), jnp.stack(a_vp), jnp.stack(a_ks), jnp.stack(a_vs),
            jnp.stack(b_kp), jnp.stack(b_vp), jnp.stack(b_ip), jnp.stack(b_ks), jnp.stack(b_vs), jnp.stack(b_is),
            jnp.stack(c_wp), jnp.stack(c_hp), jnp.stack(c_ws), jnp.stack(c_hs))
```

```cpp
#include <hip/hip_runtime.h>
#include <cstdio>
#include <cstdint>
#include <cmath>
#define MK_CUTS 1
namespace pg8 {
#define PG8_LAS __attribute__((address_space(3)))
typedef unsigned short bf16_t;
typedef short bf16x8 __attribute__((ext_vector_type(8)));
typedef float f32x4 __attribute__((ext_vector_type(4)));
typedef unsigned u32x4 __attribute__((ext_vector_type(4)));
constexpr int BM = 256, BK = 64, HALF = 128, HTB = HALF * BK * 2  , STAGE_BYTES = 8 * HTB, NXCD = 8, WGM = 8;

__host__ __device__ __forceinline__ int lds_byte(int r, int c) { const int st = (r >> 4) * 2 + (c >> 5), rr = r & 15, cc = c & 31, ob = rr * 64 + cc * 2; return st * 1024 + (ob ^ (((ob >> 9) & 1) << 5)); }
__host__ __device__ __forceinline__ void stage_rc(int b, int& R, int& C) { const int st = b / 1024, sb = b % 1024, swz = sb ^ (((sb >> 9) & 1) << 5); R = (st >> 1) * 16 + swz / 64; C = (st & 1) * 32 + (swz % 64) / 2; }
__host__ __device__ __forceinline__ int perm32(int rho) { const int n = rho >> 4, i = rho & 15; return 8 * (i >> 2) + 4 * n + (i & 3); }

struct Unit { int pm, pn, k0, nt; };
struct Gemm { const bf16_t* A; const bf16_t* Bt; int M, N, K, ld; };

struct StaticOrder {
    int nM, nN, nwg, G, c;
    __host__ __device__ void init(int M, int N, int G_, int c_) { nM = M / BM; nN = N / BM; nwg = nM * nN; G = G_; c = c_; }
    __host__ __device__ bool next(int i, Unit& u) const {
        const long L = (long)i * G + c; if (L >= nwg) return false;
        int wgid = (int)L; { const int q = nwg / NXCD, r = nwg % NXCD, xcd = wgid % NXCD, off = wgid / NXCD; wgid = (xcd < r ? xcd * (q + 1) : r * (q + 1) + (xcd - r) * q) + off; }
        const int nig = WGM * nN, gid = wgid / nig, fm = gid * WGM, gsz = (nM - fm) < WGM ? (nM - fm) : WGM;
        u.pm = fm + ((wgid % nig) % gsz); u.pn = (wgid % nig) / gsz; return true;
    }
    __device__ __forceinline__ void a_ready(const Unit&) const {}
    __device__ __forceinline__ void done(const Unit&) const {}
};
__device__ __forceinline__ unsigned cvt_pk_bf16(float lo, float hi) { unsigned r; asm volatile("v_cvt_pk_bf16_f32 %0, %1, %2" : "=v"(r) : "v"(lo), "v"(hi)); return r; }
typedef float f32x2 __attribute__((ext_vector_type(2)));
template <class Epi, class Sched, bool ALIGN_EPI = false, bool SP2 = false>
__device__ __forceinline__ void gemm_phase(PG8_LAS unsigned char* lds, const Gemm g, const Sched& S, const Epi& E) {
    const int tid = threadIdx.x, wid = __builtin_amdgcn_readfirstlane(tid >> 6), lane = tid & 63, wr = wid >> 2, wc = wid & 3, fr = lane & 15, fq = lane >> 4;
    const int K = g.ld, nt_full = g.K / BK;
    unsigned voffA[2], voffB[2];
#pragma unroll
    for (int i = 0; i < 2; ++i) { int R, C; stage_rc(tid * 16 + i * 8192, R, C); const int Rb = Epi::PERM ? ((R & ~31) + perm32(R & 31)) : R;
        voffA[i] = (unsigned)(R * K + C) * 2u; voffB[i] = (unsigned)(Rb * K + C) * 2u; }
    const size_t kstep = (size_t)(BK * 2);
    const size_t hstep = (size_t)HALF * K * 2;
    const size_t tstep = 2 * hstep;
    const unsigned ldsw = (unsigned)wid * 1024u;
    const int aoff = lds_byte(wr * 64 + fr, fq * 8), boff = lds_byte(wc * 32 + fr, fq * 8);
#define PG8_SA(b, h) (((b) * 2 + (h)) * HTB)
#define PG8_SB(b, h) ((4 + (b) * 2 + (h)) * HTB)
#define PG8_STAGE(bufoff, gbase, voff) do { _Pragma("unroll") for (int _i = 0; _i < 2; ++_i) \
        __builtin_amdgcn_global_load_lds((const unsigned*)((const char*)(gbase) + (voff)[_i]), (PG8_LAS unsigned*)(lds + (bufoff) + ldsw + _i * 8192), 16, 0, 0); } while (0)
#define PG8_LDA(dst, b, h) do { _Pragma("unroll") for (int m = 0; m < 4; ++m) _Pragma("unroll") for (int k = 0; k < 2; ++k) dst[m][k] = *(const PG8_LAS bf16x8*)(lds + PG8_SA(b, h) + aoff + m * 2048 + k * 1024); } while (0)
#define PG8_LDB(dst, b, h) do { _Pragma("unroll") for (int n = 0; n < 2; ++n) _Pragma("unroll") for (int k = 0; k < 2; ++k) dst[n][k] = *(const PG8_LAS bf16x8*)(lds + PG8_SB(b, h) + boff + n * 2048 + k * 1024); } while (0)
#define PG8_MMA(ai, bj, At, Bt) do { __builtin_amdgcn_s_setprio(1); _Pragma("unroll") for (int m = 0; m < 4; ++m) _Pragma("unroll") for (int n = 0; n < 2; ++n) _Pragma("unroll") for (int k = 0; k < 2; ++k) \
        acc[ai][bj][m][n] = __builtin_amdgcn_mfma_f32_16x16x32_bf16(Bt[n][k], At[m][k], acc[ai][bj][m][n], 0, 0, 0); __builtin_amdgcn_s_setprio(0); } while (0)
#define PG8_WAIT_V(n) asm volatile("s_waitcnt vmcnt(" #n ")" ::: "memory")
#define PG8_WAIT_L(n) asm volatile("s_waitcnt lgkmcnt(" #n ")" ::: "memory")
#define PG8_BAR __builtin_amdgcn_s_barrier()
#define PG8_SCHED __builtin_amdgcn_sched_barrier(0)
    Unit cur, nxt; int ui = 0;
    cur.k0 = 0; cur.nt = nt_full; if (!S.next(0, cur)) return;
    f32x4 acc[2][2][4][2];
#pragma unroll
    for (int a = 0; a < 2; ++a)
#pragma unroll
        for (int b = 0; b < 2; ++b)
#pragma unroll
            for (int m = 0; m < 4; ++m)
#pragma unroll
                for (int n = 0; n < 2; ++n) acc[a][b][m][n] = (f32x4){0.f, 0.f, 0.f, 0.f};
    bf16x8 At[4][2], B0[2][2], B1[2][2];
    const char* cA = (const char*)g.A + (size_t)cur.pm * tstep + (size_t)cur.k0 * 2; const char* cB = (const char*)g.Bt + (size_t)cur.pn * tstep + (size_t)cur.k0 * 2;
    S.a_ready(cur);
    if constexpr (SP2) {
        PG8_STAGE(PG8_SB(0, 0), cB, voffB); PG8_STAGE(PG8_SB(0, 1), cB + hstep, voffB); PG8_STAGE(PG8_SA(0, 0), cA, voffA); PG8_STAGE(PG8_SA(0, 1), cA + hstep, voffA);
        if (wr == 1) PG8_BAR;
        PG8_WAIT_V(2); PG8_BAR;
        PG8_STAGE(PG8_SB(1, 0), cB + kstep, voffB); PG8_STAGE(PG8_SA(1, 0), cA + kstep, voffA); PG8_STAGE(PG8_SB(1, 1), cB + hstep + kstep, voffB);
        PG8_WAIT_V(6); PG8_BAR;
    } else {
        PG8_STAGE(PG8_SB(0, 0), cB, voffB); PG8_STAGE(PG8_SA(0, 0), cA, voffA); PG8_STAGE(PG8_SB(0, 1), cB + hstep, voffB); PG8_STAGE(PG8_SA(0, 1), cA + hstep, voffA);
        if (wr == 1) PG8_BAR;
        PG8_WAIT_V(4); PG8_BAR;
        PG8_STAGE(PG8_SB(1, 0), cB + kstep, voffB); PG8_STAGE(PG8_SA(1, 0), cA + kstep, voffA); PG8_STAGE(PG8_SB(1, 1), cB + hstep + kstep, voffB);
        PG8_WAIT_V(6); PG8_BAR;
    }
    for (;;) {
        nxt.k0 = 0; nxt.nt = nt_full; const bool has_next = S.next(ui + 1, nxt); const int nt = cur.nt;
        const char* nA = has_next ? (const char*)g.A + (size_t)nxt.pm * tstep + (size_t)nxt.k0 * 2 : cA; const char* nB = has_next ? (const char*)g.Bt + (size_t)nxt.pn * tstep + (size_t)nxt.k0 * 2 : cB;
        for (int t = 0; t < nt; t += 2) {
            const bool last = (t == nt - 2);
            const char* a1 = cA + (size_t)(t + 1) * kstep;
            const char* a2 = last ? nA : cA + (size_t)(t + 2) * kstep; const char* b2 = last ? nB : cB + (size_t)(t + 2) * kstep;
            const char* a3 = a2 + kstep; const char* b3 = b2 + kstep;
            if (last && has_next) S.a_ready(nxt);
            if constexpr (SP2) {
            PG8_LDB(B0, 0, 0); PG8_LDB(B1, 0, 1); PG8_SCHED; PG8_LDA(At, 0, 0); PG8_STAGE(PG8_SA(1, 1), a1 + hstep, voffA);
            PG8_WAIT_V(8); PG8_WAIT_L(0); PG8_BAR; PG8_MMA(0, 0, At, B0); PG8_MMA(0, 1, At, B1); PG8_BAR; PG8_SCHED;
            PG8_LDA(At, 0, 1); PG8_STAGE(PG8_SB(0, 0), b2, voffB); PG8_STAGE(PG8_SB(0, 1), b2 + hstep, voffB); PG8_STAGE(PG8_SA(0, 0), a2, voffA);
            PG8_WAIT_V(8); PG8_WAIT_L(0); PG8_BAR; PG8_MMA(1, 0, At, B0); PG8_MMA(1, 1, At, B1); PG8_BAR; PG8_SCHED;
            PG8_LDB(B0, 1, 0); PG8_LDB(B1, 1, 1); PG8_SCHED; PG8_LDA(At, 1, 0); PG8_STAGE(PG8_SA(0, 1), a2 + hstep, voffA);
            PG8_WAIT_V(8); PG8_WAIT_L(0); PG8_BAR; PG8_MMA(0, 0, At, B0); PG8_MMA(0, 1, At, B1); PG8_BAR; PG8_SCHED;
            PG8_LDA(At, 1, 1); PG8_STAGE(PG8_SB(1, 0), b3, voffB); PG8_STAGE(PG8_SB(1, 1), b3 + hstep, voffB); PG8_STAGE(PG8_SA(1, 0), a3, voffA);
            PG8_WAIT_V(8); PG8_WAIT_L(0); PG8_BAR; PG8_MMA(1, 0, At, B0); PG8_MMA(1, 1, At, B1); PG8_BAR; PG8_SCHED;
            } else {
            PG8_LDB(B0, 0, 0); PG8_SCHED; PG8_LDA(At, 0, 0); PG8_STAGE(PG8_SA(1, 1), a1 + hstep, voffA);
            PG8_WAIT_L(8); PG8_BAR; PG8_WAIT_L(0); PG8_MMA(0, 0, At, B0); PG8_BAR; PG8_SCHED;
            PG8_LDB(B1, 0, 1); PG8_STAGE(PG8_SB(0, 0), b2, voffB);
            PG8_BAR; PG8_WAIT_L(0); PG8_MMA(0, 1, At, B1); PG8_BAR;
            PG8_LDA(At, 0, 1); PG8_STAGE(PG8_SA(0, 0), a2, voffA);
            PG8_BAR; PG8_WAIT_L(0); PG8_MMA(1, 0, At, B0); PG8_BAR; PG8_SCHED;
            PG8_STAGE(PG8_SB(0, 1), b2 + hstep, voffB);
            PG8_WAIT_V(6); PG8_BAR; PG8_MMA(1, 1, At, B1); PG8_BAR;
            PG8_LDB(B0, 1, 0); PG8_SCHED; PG8_LDA(At, 1, 0); PG8_STAGE(PG8_SA(0, 1), a2 + hstep, voffA);
            PG8_WAIT_L(8); PG8_BAR; PG8_WAIT_L(0); PG8_MMA(0, 0, At, B0); PG8_BAR; PG8_SCHED;
            PG8_LDB(B1, 1, 1); PG8_STAGE(PG8_SB(1, 0), b3, voffB);
            PG8_BAR; PG8_WAIT_L(0); PG8_MMA(0, 1, At, B1); PG8_BAR;
            PG8_LDA(At, 1, 1); PG8_STAGE(PG8_SA(1, 0), a3, voffA);
            PG8_BAR; PG8_WAIT_L(0); PG8_MMA(1, 0, At, B0); PG8_BAR; PG8_SCHED;
            PG8_STAGE(PG8_SB(1, 1), b3 + hstep, voffB);
            PG8_WAIT_V(6); PG8_BAR; PG8_MMA(1, 1, At, B1); PG8_BAR;
            }
        }
        if constexpr (ALIGN_EPI) { if (wr == 0) PG8_BAR; }
        if constexpr (!Epi::AFTER_DRAIN) { E(acc, cur, wr, wc, fr, fq); S.done(cur); }
        if (!has_next) break;
#pragma unroll
        for (int a = 0; a < 2; ++a)
#pragma unroll
            for (int b = 0; b < 2; ++b)
#pragma unroll
                for (int m = 0; m < 4; ++m)
#pragma unroll
                    for (int n = 0; n < 2; ++n) acc[a][b][m][n] = (f32x4){0.f, 0.f, 0.f, 0.f};
        cur = nxt; cA = nA; cB = nB; ++ui;
        if constexpr (ALIGN_EPI) { if (wr == 1) PG8_BAR; }
    }
    PG8_WAIT_V(0);
    if constexpr (!ALIGN_EPI) { if (wr == 0) PG8_BAR; }
    PG8_BAR;
    if constexpr (Epi::AFTER_DRAIN) { E.fused(acc, cur, wr, wc, fr, fq, lds, wid, lane); S.done(cur); }
#undef PG8_SA
#undef PG8_SB
#undef PG8_STAGE
#undef PG8_LDA
#undef PG8_LDB
#undef PG8_MMA
#undef PG8_WAIT_V
#undef PG8_WAIT_L
#undef PG8_BAR
#undef PG8_SCHED
}
}
#define GAS __attribute__((address_space(1)))
#define LAS __attribute__((address_space(3)))
typedef unsigned short bf16;
typedef unsigned v4u __attribute__((ext_vector_type(4)));
typedef unsigned v2u __attribute__((ext_vector_type(2)));
typedef float f32x4 __attribute__((ext_vector_type(4)));
typedef float f32x2 __attribute__((ext_vector_type(2)));
typedef float f32x16 __attribute__((ext_vector_type(16)));
typedef short bf16x8 __attribute__((ext_vector_type(8)));
typedef short s16x4 __attribute__((ext_vector_type(4)));
typedef GAS unsigned gu32;

constexpr int D = 2048, NP = 8192, NS = 512, M = NP + NS, TP = 2048, TS = 64, PAST = 4096, SALL = PAST + TS, NPOS = TP + TS;
constexpr int NWAVES = 8, NTHR = 512;
constexpr float LOG2E = 1.4426950408889634f;
constexpr float QSCALE_A = 0.125f * LOG2E, QSCALE_B = 0.08838834764831845f * LOG2E;
constexpr int NA_TILES = 32, NB_TILES = 25, NC1_TILES = 34, NC2_TILES = 16;
constexpr int MASKW = 132;

constexpr size_t O_YP = 0, O_YS = O_YP + (size_t)NP * D, O_AKP = O_YS + (size_t)NS * D, O_AVP = O_AKP + 2ull * NP * D, O_AKS = O_AVP + 2ull * NP * D, O_AVS = O_AKS + 2ull * NS * D,
                 O_BKP = O_AVS + 2ull * NS * D, O_BVP = O_BKP + (size_t)NP * 512, O_BIP = O_BVP + (size_t)NP * 512, O_BKS = O_BIP + (size_t)NP * 64, O_BVS = O_BKS + (size_t)NS * 512, O_BIS = O_BVS + (size_t)NS * 512,
                 O_CWP = O_BIS + (size_t)NS * 64, O_CHP = O_CWP + 4ull * 32 * 4096, O_CWS = O_CHP + 4ull * D, O_CHS = O_CWS + 8ull * 32 * 4096, O_TOTAL = O_CHS + 8ull * D;

constexpr size_t MiB = 1u << 20;
#if MK_CUTS == 1
constexpr size_t WS_CTL = 0, CTL_ZERO_BYTES = 40 * 1024;
#else
constexpr size_t WS_CTL = 0, CTL_ZERO_BYTES = 1 * MiB;
#endif
constexpr size_t WS_TAB64 = 3 * MiB;
constexpr size_t WS_TAB128 = WS_TAB64 + (size_t)NPOS * 32 * 8;
constexpr size_t WS_WA = 5 * MiB;
constexpr size_t WS_WB = WS_WA + 2ull * 8192 * 2048 * 2;
constexpr size_t WS_WC1 = WS_WB + 6400ull * 2048 * 2;
constexpr size_t WS_WC2 = WS_WC1 + 8704ull * 2048 * 2;
constexpr size_t WS_WO = WS_WC2 + 4096ull * 256 * 2;
constexpr size_t WS_XRES = WS_WO + 4ull * 2048 * 2048 * 2;
constexpr size_t MD2 = (size_t)M * D * 2, MD4 = (size_t)M * D * 4;
constexpr size_t WS_OB = WS_XRES + MD4;
constexpr size_t WS_PART = WS_OB + MD2;
constexpr size_t WS_XS = WS_PART + 8ull * NS * D * 4;
constexpr size_t WS_APART = WS_XS + 2ull * NS * D * 4;
constexpr size_t WS_U = WS_APART + 8ull * NS * 32 * 130 * 4;
constexpr size_t WS_HB = WS_U;
constexpr size_t WS_QA = WS_HB + MD2, WS_KA = WS_QA + MD2, WS_VA = WS_KA + MD2, WS_GA = WS_VA + MD2;
constexpr size_t WS_QB = WS_HB + MD2, WS_GB = WS_QB + MD2, WS_KB = WS_GB + MD2, WS_VB = WS_KB + (size_t)M * 512 * 2, WS_QI = WS_VB + (size_t)M * 512 * 2,
                 WS_KI = WS_QI + (size_t)M * 1024 * 2, WS_WI = WS_KI + (size_t)M * 64 * 2, WS_MASK = WS_WI + (size_t)M * 16 * 4, WS_SC = WS_MASK + (size_t)M * MASKW * 4;
constexpr size_t SC_S_OFF = (size_t)NP * 2048;
constexpr size_t WS_B_END = WS_SC + ((size_t)NP * 2048 + (size_t)NS * 4160) * 4;
constexpr size_t WS_L6 = WS_U;
constexpr size_t WS_R = WS_L6 + 6 * MD2, WS_K = WS_R + MD4, WS_V = WS_K + MD4, WS_G = WS_V + MD4, WS_DEC = WS_G + MD4, WS_AS = WS_DEC + MD4, WS_XL = WS_AS + MD4;
constexpr size_t WS_C_END = WS_XL + (size_t)M * 256 * 2;
constexpr size_t WS_END0 = (WS_C_END > WS_B_END ? WS_C_END : WS_B_END);
constexpr size_t WS_KC = (WS_END0 + 4095) & ~(size_t)4095;
constexpr size_t WS_VC = WS_KC + 8ull * PAST * D * 2;
constexpr size_t WS_END = WS_VC + 8ull * PAST * D * 2;
#if MK_CUTS == 1
constexpr int CW_TMO = 0, CW_BAR = 4096, N_BAR_REGIONS = 1;
#else
constexpr int CW_TMO = 0, CW_BAR = 4096, N_BAR_REGIONS = 24;
#endif
static_assert((CW_BAR + N_BAR_REGIONS * 3456) * 4 <= (int)CTL_ZERO_BYTES, "ctl");
constexpr int RING_BYTES = 131072, LDS_BYTES = 147456, MISC_OFF = LDS_BYTES - 512;

__device__ __forceinline__ unsigned f2bf(float f) { unsigned u = __builtin_bit_cast(unsigned, f); return (u + 0x7fffu + ((u >> 16) & 1u)) >> 16; }
__device__ __forceinline__ unsigned pk2(float lo, float hi) { return f2bf(lo) | (f2bf(hi) << 16); }
__device__ __forceinline__ unsigned cvtpk(float lo, float hi) { typedef __bf16 b2 __attribute__((ext_vector_type(2))); f32x2 v = {lo, hi}; b2 b = __builtin_convertvector(v, b2); return __builtin_bit_cast(unsigned, b); }
__device__ __forceinline__ float bf_lo(unsigned u) { return __builtin_bit_cast(float, u << 16); }
__device__ __forceinline__ float bf_hi(unsigned u) { return __builtin_bit_cast(float, u & 0xffff0000u); }
__device__ __forceinline__ float silu_f(float x) { return x * __builtin_amdgcn_rcpf(1.f + __expf(-x)); }
__device__ __forceinline__ float wave_sum(float v) {
#pragma unroll
    for (int o = 1; o < 64; o <<= 1) v += __shfl_xor(v, o);
    return v;
}
__device__ __forceinline__ int pos_index(int row) { return row < NP ? (row & (TP - 1)) : TP + ((row - NP) & (TS - 1)); }
__device__ __forceinline__ int lane_now() { return (int)__builtin_amdgcn_mbcnt_hi(~0u, __builtin_amdgcn_mbcnt_lo(~0u, 0u)); }
#define LDS_WAIT() asm volatile("s_waitcnt lgkmcnt(0)" ::: "memory")
#define VM_WAIT() asm volatile("s_waitcnt vmcnt(0)" ::: "memory")

struct Args { const float* in[29]; float* out; unsigned char* ws; int ph_lo, ph_hi, li, pad; };
struct Frame {
    LAS unsigned char* lds;
    int tid, lane, wave, G, bid;
    const __attribute__((address_space(4))) Args* a; float* out; unsigned char* ws; unsigned* census;
};

__device__ __forceinline__ int orig64(int s) { const int wc = s >> 5, n = (s >> 4) & 1, r = s & 15; return 64 * (wc >> 1) + 32 * n + 16 * (wc & 1) + r; }
__device__ __forceinline__ int orig128(int s) { const int wc = s >> 5, n = (s >> 4) & 1, r = s & 15; return 64 * n + 16 * wc + r; }
enum MapId { MAP_ID = 0, MAP_A = 1, MAP_B = 2, MAP_PAD96 = 3 };
__device__ __forceinline__ int wide256(int s) { const int bj = s >> 7, wc = (s >> 5) & 3, nn = (s >> 4) & 1, fq = (s >> 2) & 3, e = s & 3; return 64 * wc + 32 * bj + 8 * fq + 4 * nn + e; }
__device__ __forceinline__ int colmap(int map, int n) {
    if (map == MAP_ID) return n;
    if (map == MAP_PAD96) return n < 96 ? n : -1;
    const int T = n >> 8, base = n & ~127, s = n & 127, bj = (n >> 7) & 1, wide = (n & ~255) + wide256(n & 255);
    if (map == MAP_A) return wide;
    if (T < 10) return base + orig128(s);
    if (T < 16) return wide;
    if (T == 16) { if (bj) return -1; const int o = orig64(s); return o < 64 ? 4096 + o : (o < 80 ? 4160 + (o - 64) : -1); }
    return 4176 + (wide - 17 * 256);
}
__device__ __forceinline__ void conv_item(const float* W, int ldw, bf16* WT, int ldd, int map, int item, int nblk, LAS float* scr, int lane) {
    const int kb = item / nblk, nb = item % nblk, k0 = 64 * kb, n0 = 32 * nb;
    const int n4 = lane & 7, kr = lane >> 3;
    const int src = colmap(map, n0 + 4 * n4);
    f32x4 v[8];
#pragma unroll
    for (int i = 0; i < 8; ++i) v[i] = src >= 0 ? *(const GAS f32x4*)(W + (size_t)(k0 + kr + 8 * i) * ldw + src) : (f32x4){0.f, 0.f, 0.f, 0.f};
#pragma unroll
    for (int i = 0; i < 8; ++i) { LAS float* p = scr + (kr + 8 * i) * 33 + 4 * n4; p[0] = v[i][0]; p[1] = v[i][1]; p[2] = v[i][2]; p[3] = v[i][3]; }
    LDS_WAIT(); asm volatile("" ::: "memory");
    const int c = lane & 7;
#pragma unroll
    for (int j = 0; j < 4; ++j) { const int n = (lane >> 3) + 8 * j; const LAS float* s = scr + (8 * c) * 33 + n;
        v4u o; o.x = cvtpk(s[0 * 33], s[1 * 33]); o.y = cvtpk(s[2 * 33], s[3 * 33]); o.z = cvtpk(s[4 * 33], s[5 * 33]); o.w = cvtpk(s[6 * 33], s[7 * 33]);
        *(GAS v4u*)(WT + (size_t)(n0 + n) * ldd + k0 + 8 * c) = o; }
    LDS_WAIT(); asm volatile("" ::: "memory");
}
template <bool WIDE> __device__ __forceinline__ int rix(int lane, int j) { return WIDE ? 2 * lane + (j & 1) + 128 * (j >> 1) : lane + 64 * j; }
template <bool WIDE = false>
__device__ __forceinline__ void rms_row(const float* xrow, const float* g, int lane, f32x4 (&v)[8], const float* part = nullptr, float* wb = nullptr) {
    const GAS f32x4* xr = (const GAS f32x4*)xrow; float s = 0.f;
#pragma unroll
    for (int j = 0; j < 8; ++j) v[j] = xr[rix<WIDE>(lane, j)];
    if (part) {
#pragma unroll
        for (int sl = 0; sl < 8; ++sl) { const GAS f32x4* pr = (const GAS f32x4*)(part + (size_t)sl * NS * D);
#pragma unroll
            for (int j = 0; j < 8; ++j) v[j] = v[j] + pr[rix<WIDE>(lane, j)]; }
        if (wb) { GAS f32x4* o = (GAS f32x4*)wb;
#pragma unroll
            for (int j = 0; j < 8; ++j) o[rix<WIDE>(lane, j)] = v[j]; } }
#pragma unroll
    for (int j = 0; j < 8; ++j) s += (v[j].x * v[j].x + v[j].y * v[j].y) + (v[j].z * v[j].z + v[j].w * v[j].w);
    const float r = rsqrtf(wave_sum(s) * (1.f / D) + 1e-6f);
    const GAS f32x4* gr = (const GAS f32x4*)g;
#pragma unroll
    for (int j = 0; j < 8; ++j) v[j] = v[j] * r * gr[rix<WIDE>(lane, j)];
}
__device__ __forceinline__ const float* xrow_ptr(const float* xp, const float* xs, int row) { return row < NP ? xp + (size_t)row * D : xs + (size_t)(row - NP) * D; }
__device__ __forceinline__ int norm_row(int gw, int NGW, int k) {
    if (NGW != 2048) { const int r = gw + k * NGW; return r < M ? r : -1; }
    if (gw < 512) return k == 0 ? NP + gw : (k == 1 ? 7680 + gw : -1);
    const int r = (gw - 512) + k * 1536; return r < 7680 ? r : -1;
}
__device__ __forceinline__ void p_norm(Frame& F, const float* xp, const float* xs, const float* g, int mode, bool merge, float* xs_out) {
    const int gw = F.bid * NWAVES + F.wave, NGW = F.G * NWAVES;
    bf16* HB = (bf16*)(F.ws + WS_HB);
    for (int k = 0;; ++k) { const int row = norm_row(gw, NGW, k); if (row < 0) break;
        f32x4 v[8]; const float* part = row >= NP ? (const float*)(F.ws + WS_PART) + (size_t)(row - NP) * D : nullptr;
        rms_row(xrow_ptr(xp, xs, row), g, lane_now(), v, merge ? part : nullptr, xs_out + (size_t)(row - NP) * D);
        if (mode == 0) { GAS v2u* o = (GAS v2u*)(HB + (size_t)row * D) + lane_now();
#pragma unroll
            for (int j = 0; j < 8; ++j) { v2u w; w.x = cvtpk(v[j].x, v[j].y); w.y = cvtpk(v[j].z, v[j].w); o[64 * j] = w; } }
        else { float* y = row < NP ? F.out + O_YP + (size_t)row * D : F.out + O_YS + (size_t)(row - NP) * D; GAS f32x4* o = (GAS f32x4*)y + lane_now();
#pragma unroll
            for (int j = 0; j < 8; ++j) o[64 * j] = v[j]; }
    }
}
__device__ __forceinline__ void p_norm_lerp(Frame& F, const float* xp, const float* xs, const float* g, float* xs_out) {
    const int gw = F.bid * NWAVES + F.wave, NGW = F.G * NWAVES;
    bf16* L6 = (bf16*)(F.ws + WS_L6); const float* mu = F.a->in[16]; const float* shift0 = F.a->in[8];
    const int lane = F.lane;
    auto emit = [&](int row, const f32x4 (&h)[8], const f32x4 (&pvv)[8]) {
#pragma unroll
        for (int n = 0; n < 6; ++n) { const GAS f32x4* mr = (const GAS f32x4*)(mu + (size_t)n * D); GAS v4u* o = (GAS v4u*)(L6 + ((size_t)n * M + row) * D) + lane;
#pragma unroll
            for (int jj = 0; jj < 4; ++jj) { const f32x4 m0 = mr[rix<true>(lane, 2 * jj)], m1 = mr[rix<true>(lane, 2 * jj + 1)];
                const f32x4 l0 = h[2 * jj] + (pvv[2 * jj] - h[2 * jj]) * m0, l1 = h[2 * jj + 1] + (pvv[2 * jj + 1] - h[2 * jj + 1]) * m1;
                v4u w; w.x = cvtpk(l0.x, l0.y); w.y = cvtpk(l0.z, l0.w); w.z = cvtpk(l1.x, l1.y); w.w = cvtpk(l1.z, l1.w); o[64 * jj] = w; } } };
    auto pair = [&](int r0) {
        const int t0 = r0 & (TP - 1), b = r0 / TP; f32x4 a[8], h0[8], h1[8];
        const GAS f32x4* x0 = (const GAS f32x4*)(xp + (size_t)r0 * D); const GAS f32x4* xa = t0 > 0 ? x0 - D / 4 : x0; const GAS f32x4* x1 = x0 + D / 4;
#pragma unroll
        for (int j = 0; j < 8; ++j) { const int ix = rix<true>(lane, j); a[j] = xa[ix]; h0[j] = x0[ix]; h1[j] = x1[ix]; }
        float sa = 0.f, s0 = 0.f, s1 = 0.f;
#pragma unroll
        for (int j = 0; j < 8; ++j) { sa += (a[j].x * a[j].x + a[j].y * a[j].y) + (a[j].z * a[j].z + a[j].w * a[j].w); s0 += (h0[j].x * h0[j].x + h0[j].y * h0[j].y) + (h0[j].z * h0[j].z + h0[j].w * h0[j].w);
            s1 += (h1[j].x * h1[j].x + h1[j].y * h1[j].y) + (h1[j].z * h1[j].z + h1[j].w * h1[j].w); }
        const float ra = t0 > 0 ? rsqrtf(wave_sum(sa) * (1.f / D) + 1e-6f) : 0.f, q0 = rsqrtf(wave_sum(s0) * (1.f / D) + 1e-6f), q1 = rsqrtf(wave_sum(s1) * (1.f / D) + 1e-6f);
        const GAS f32x4* gr = (const GAS f32x4*)g;
#pragma unroll
        for (int j = 0; j < 8; ++j) { const f32x4 gg = gr[rix<true>(lane, j)]; a[j] = a[j] * ra * gg; h0[j] = h0[j] * q0 * gg; h1[j] = h1[j] * q1 * gg; }
        if (t0 + 1 == TP - 1) { GAS f32x4* o = (GAS f32x4*)(F.out + O_CHP + (size_t)b * D);
#pragma unroll
            for (int j = 0; j < 8; ++j) o[rix<true>(lane, j)] = h1[j]; }
        emit(r0, h0, a); emit(r0 + 1, h1, h0); };
    auto single = [&](int row) {
        const bool samp = row >= NP; const int t = samp ? (row - NP) & (TS - 1) : row & (TP - 1); const int b = samp ? (row - NP) / TS : row / TP;
        const float* part = samp ? (const float*)(F.ws + WS_PART) + (size_t)(row - NP) * D : nullptr;
        f32x4 h[8], pv[8]; rms_row<true>(xrow_ptr(xp, xs, row), g, lane, h, part, xs_out + (size_t)(row - NP) * D);
        if (t > 0) rms_row<true>(xrow_ptr(xp, xs, row - 1), g, lane, pv, samp ? part - D : nullptr, nullptr);
        else {
#pragma unroll
            for (int j = 0; j < 8; ++j) pv[j] = samp ? ((const GAS f32x4*)(shift0 + (size_t)b * D))[rix<true>(lane, j)] : (f32x4){0.f, 0.f, 0.f, 0.f}; }
        const bool last = samp ? (t == TS - 1) : (t == TP - 1);
        if (last) { float* so = samp ? F.out + O_CHS + (size_t)b * D : F.out + O_CHP + (size_t)b * D; GAS f32x4* o = (GAS f32x4*)so;
#pragma unroll
            for (int j = 0; j < 8; ++j) o[rix<true>(lane, j)] = h[j]; }
#pragma unroll
        for (int j = 0; j < 8; ++j) pv[j] = pv[j] - h[j];
#pragma unroll
        for (int n = 0; n < 6; ++n) { const GAS f32x4* mr = (const GAS f32x4*)(mu + (size_t)n * D); GAS v4u* o = (GAS v4u*)(L6 + ((size_t)n * M + row) * D) + lane;
#pragma unroll
            for (int jj = 0; jj < 4; ++jj) { const f32x4 l0 = h[2 * jj] + pv[2 * jj] * mr[rix<true>(lane, 2 * jj)], l1 = h[2 * jj + 1] + pv[2 * jj + 1] * mr[rix<true>(lane, 2 * jj + 1)];
                v4u w; w.x = cvtpk(l0.x, l0.y); w.y = cvtpk(l0.z, l0.w); w.z = cvtpk(l1.x, l1.y); w.w = cvtpk(l1.z, l1.w); o[64 * jj] = w; } }
    };
    if (NGW == 2048) {
        if (gw < 512) { single(NP + gw); single(7680 + gw); }
        else { for (int k = 0; k < 3; ++k) { const int pr = (gw - 512) + 1536 * k; if (pr < 3840) pair(2 * pr); } }
    } else { for (int k = 0;; ++k) { const int row = norm_row(gw, NGW, k); if (row < 0) break; single(row); } }
}
constexpr int CONV_ITEMS = 8192 * 2 + 6400 + 2048 * 4 + 256 * 2 + 2048 * 4;
__device__ __forceinline__ bool conv_is_deferred(int it) { return (it >= 8192 && it < 16384 + 6400 + 8192 + 512) || it >= CONV_ITEMS - 4096; }
__device__ __forceinline__ void conv_dispatch(Frame& F, int it, LAS float* scr) {
    bf16* WA = (bf16*)(F.ws + WS_WA); bf16* WB = (bf16*)(F.ws + WS_WB); bf16* WC1 = (bf16*)(F.ws + WS_WC1); bf16* WO = (bf16*)(F.ws + WS_WO);
    int r = it; const float* W; int ldw, map, rows; bf16* dst;
    if (r < 16384) { const int j = r >> 13; r &= 8191; W = F.a->in[12] + (size_t)j * D * 8192; ldw = 8192; map = MAP_A; dst = WA + (size_t)j * 8192 * D; rows = 8192; }
    else if ((r -= 16384) < 6400) { W = F.a->in[15]; ldw = 6224; map = MAP_B; dst = WB; rows = 6400; }
    else if ((r -= 6400) < 8192) { const int j = r >> 11; r &= 2047; W = F.a->in[17] + (size_t)j * D * D; ldw = D; map = MAP_ID; dst = WC1 + (size_t)j * D * D; rows = 2048; }
    else if ((r -= 8192) < 256) { W = F.a->in[19]; ldw = 96; map = MAP_PAD96; dst = WC1 + (size_t)8192 * D; rows = 256; }
    else if ((r -= 256) < 256) { W = F.a->in[22]; ldw = 96; map = MAP_PAD96; dst = WC1 + (size_t)8448 * D; rows = 256; }
    else { r -= 256; const int j = r >> 11; r &= 2047; W = F.a->in[11] + (size_t)j * D * D; ldw = D; map = MAP_ID; dst = WO + (size_t)j * D * D; rows = 2048; }
    conv_item(W, ldw, dst, D, map, r, rows / 32, scr, F.lane);
}
__device__ __forceinline__ void conv_deferred2(Frame& F, int wg_rank, int nwg) {
    LAS float* scr = (LAS float*)(F.lds + F.wave * 16384);
    for (int k = wg_rank * NWAVES + F.wave; k < 6400 + 8192 + 512; k += nwg * NWAVES) conv_dispatch(F, 16384 + k, scr);
}
__device__ __forceinline__ void conv_deferred(Frame& F, int wg_rank, int nwg) {
    LAS float* scr = (LAS float*)(F.lds + F.wave * 16384);
    for (int k = wg_rank * NWAVES + F.wave; k < 8192 + 4096; k += nwg * NWAVES) { const int it = k < 8192 ? 8192 + k : CONV_ITEMS - 4096 + (k - 8192); conv_dispatch(F, it, scr); }
}
__device__ __forceinline__ void p0_prologue(Frame& F) {
    LAS float* scr = (LAS float*)(F.lds + F.wave * 16384);
    const int gw = F.bid * NWAVES + F.wave, NGW = F.G * NWAVES;
    bf16* WA = (bf16*)(F.ws + WS_WA); bf16* WB = (bf16*)(F.ws + WS_WB); bf16* WC1 = (bf16*)(F.ws + WS_WC1); bf16* WC2 = (bf16*)(F.ws + WS_WC2); bf16* WO = (bf16*)(F.ws + WS_WO);
    for (int it = gw; it < CONV_ITEMS; it += NGW) { if (!conv_is_deferred(it)) conv_dispatch(F, it, scr); }
    { const float* wlb = F.a->in[20]; const float* alb = F.a->in[23];
      for (int idx = (F.bid * NTHR + F.tid); idx < 4096 * 256; idx += F.G * NTHR) { const int k = idx >> 12, n = idx & 4095; float v = 0.f;
          if (n < 2048) { if (k < 96) v = wlb[(size_t)k * D + n]; } else { if (k >= 128 && k < 224) v = alb[(size_t)(k - 128) * D + (n - 2048)]; }
          WC2[(size_t)n * 256 + k] = (bf16)f2bf(v); } }
    { f32x2* t64 = (f32x2*)(F.ws + WS_TAB64); f32x2* t128 = (f32x2*)(F.ws + WS_TAB128);
      for (int idx = (F.bid * NTHR + F.tid); idx < NPOS * 96; idx += F.G * NTHR) { const int p = idx / 96, j = idx % 96; const float pos = (float)(p < TP ? p : PAST + (p - TP));
          if (j < 32) { const float inv = powf(10000.0f, -(float)j * (2.0f / 64.f)); const float a = pos * inv; t64[p * 32 + j] = (f32x2){cosf(a), sinf(a)}; }
          else { const int jj = j - 32; const float inv = powf(10000.0f, -(float)jj * (2.0f / 128.f)); const float a = pos * inv; t128[p * 64 + jj] = (f32x2){cosf(a), sinf(a)}; } } }
    p_norm(F, F.a->in[0], F.a->in[1], F.a->in[9], 0, false, nullptr);
}
#ifndef MK_EXPG
#define MK_EXPG 0
#endif
#ifndef MK_NTA
#define MK_NTA 1
#endif
namespace pg8 {
__device__ __forceinline__ void st_a(const f32x4 v, float* p) { if (MK_NTA) __builtin_nontemporal_store(v, (f32x4*)p); else *(f32x4*)p = v; }
template <int BANK> __device__ __forceinline__ float ror8_merge(float old, float src) { return __builtin_bit_cast(float, __builtin_amdgcn_update_dpp(__builtin_bit_cast(int, old), __builtin_bit_cast(int, src), 0x128, 0xf, BANK, false)); }
__device__ __forceinline__ void rowpair(const f32x4 A, const f32x4 B, bool lo, f32x4& s1, f32x4& s2) {
#pragma unroll
    for (int e = 0; e < 4; ++e) { const float send = lo ? B[e] : A[e]; s1[e] = ror8_merge<0xC>(A[e], send); s2[e] = ror8_merge<0x3>(B[e], send); }
}
__device__ __forceinline__ void rope4(const f32x4 x1, const f32x4 x2, const f32x4 csa, const f32x4 csb, f32x4& o1, f32x4& o2) {
    o1[0] = x1[0] * csa[0] - x2[0] * csa[1]; o2[0] = x2[0] * csa[0] + x1[0] * csa[1];
    o1[1] = x1[1] * csa[2] - x2[1] * csa[3]; o2[1] = x2[1] * csa[2] + x1[1] * csa[3];
    o1[2] = x1[2] * csb[0] - x2[2] * csb[1]; o2[2] = x2[2] * csb[0] + x1[2] * csb[1];
    o1[3] = x1[3] * csb[2] - x2[3] * csb[3]; o2[3] = x2[3] * csb[2] + x1[3] * csb[3];
}
typedef unsigned u32x2 __attribute__((ext_vector_type(2)));
__device__ __forceinline__ u32x2 pack4(const f32x4 v) { u32x2 w; w.x = cvt_pk_bf16(v[0], v[1]); w.y = cvt_pk_bf16(v[2], v[3]); return w; }
__device__ __forceinline__ int pos_index_(int row) { return row < 8192 ? (row & 2047) : 2048 + ((row - 8192) & 63); }
__device__ __forceinline__ float silu_(float x) { return x * __builtin_amdgcn_rcpf(1.f + __expf(-x)); }
__device__ __forceinline__ f32x4 silu4(const f32x4 v) { return (f32x4){silu_(v[0]), silu_(v[1]), silu_(v[2]), silu_(v[3])}; }

__device__ __forceinline__ u32x4 pack8(const f32x4 a, const f32x4 b) { u32x4 w; w.x = cvt_pk_bf16(a[0], a[1]); w.y = cvt_pk_bf16(a[2], a[3]); w.z = cvt_pk_bf16(b[0], b[1]); w.w = cvt_pk_bf16(b[2], b[3]); return w; }
__device__ __forceinline__ void keep4(const f32x4 v) { asm volatile("" :: "v"(v[0]), "v"(v[1]), "v"(v[2]), "v"(v[3])); }
__device__ __forceinline__ void st2_bf16(bf16_t* p, int p8, const u32x4 A, const u32x4 B, bool lo, bool dry = false) { f32x4 s1, s2; rowpair(__builtin_bit_cast(f32x4, A), __builtin_bit_cast(f32x4, B), lo, s1, s2);
    if (MK_EXPG == 6 && dry) { keep4(s1); keep4(s2); asm volatile("" :: "v"(p)); return; }
    *(u32x4*)p = __builtin_bit_cast(u32x4, s1); *(u32x4*)(p + p8) = __builtin_bit_cast(u32x4, s2); }
template <bool NT> __device__ __forceinline__ void st2_f32(float* p, int p8, const f32x4 A, const f32x4 B, bool lo, bool dry = false) { f32x4 s1, s2; rowpair(A, B, lo, s1, s2);
    if (MK_EXPG == 6 && dry) { keep4(s1); keep4(s2); asm volatile("" :: "v"(p)); return; }
    if (NT) { __builtin_nontemporal_store(s1, (f32x4*)p); __builtin_nontemporal_store(s2, (f32x4*)(p + p8)); } else { *(f32x4*)p = s1; *(f32x4*)(p + p8) = s2; } }
__device__ __forceinline__ void rope8(const float* tab64, int row, int fq, const f32x4 x1a, const f32x4 x2a, const f32x4 x1b, const f32x4 x2b, f32x4& a1, f32x4& a2, f32x4& b1, f32x4& b2) {
    const float* tp = tab64 + ((size_t)pos_index_(row) * 32 + 8 * fq) * 2;
    const f32x4 c0 = *(const f32x4*)tp, c1 = *(const f32x4*)(tp + 4), c2 = *(const f32x4*)(tp + 8), c3 = *(const f32x4*)(tp + 12);
    rope4(x1a, x2a, c0, c1, a1, a2); rope4(x1b, x2b, c2, c3, b1, b2);
}
struct EpiAIn {
    static constexpr bool PERM = false, AFTER_DRAIN = false;
    bf16_t *QA, *KA, *VA, *GA; float *okp, *oks, *ovp, *ovs; const float* tab64; float qscale; int xskip = 0;
    __device__ __forceinline__ void operator()(const f32x4 (&acc)[2][2][4][2], const Unit& u, int wr, int wc, int fr, int fq) const {
        const int T = u.pn, type = T >> 3; const bool lo = fr < 8;
        if (MK_EXPG && MK_EXPG != 6 && xskip) return; const bool dry = MK_EXPG == 6 && xskip;
        const int cw = (T & 7) * 256 + 64 * wc + 8 * fq;
#pragma unroll
        for (int ai = 0; ai < 2; ++ai)
#pragma unroll
            for (int m = 0; m < 4; ++m) {
                const int rowb = u.pm * BM + ai * HALF + wr * 64 + m * 16, row0 = rowb + (fr & 7); const size_t ro0 = (size_t)row0 * 2048;
                float* f0 = row0 < 8192 ? (type == 1 ? okp : ovp) + ro0 : (type == 1 ? oks : ovs) + (ro0 - (size_t)8192 * 2048);
                if (type < 2) {
                    f32x4 a1, a2, b1, b2; rope8(tab64, rowb + fr, fq, acc[ai][0][m][0], acc[ai][1][m][0], acc[ai][0][m][1], acc[ai][1][m][1], a1, a2, b1, b2);
                    if (type == 0) { a1 = a1 * qscale; a2 = a2 * qscale; b1 = b1 * qscale; b2 = b2 * qscale; }
                    st2_bf16((type == 0 ? QA : KA) + ro0 + cw + (lo ? 0 : 32), 8 * 2048, pack8(a1, b1), pack8(a2, b2), lo, dry);
                    if (type == 1) { st2_f32<true>(f0 + cw + (lo ? 0 : 4), 8 * 2048, a1, b1, lo, dry); st2_f32<true>(f0 + cw + 32 + (lo ? 0 : 4), 8 * 2048, a2, b2, lo, dry); }
                } else if (type == 2) {
                    st2_bf16(VA + ro0 + cw + (lo ? 0 : 32), 8 * 2048, pack8(acc[ai][0][m][0], acc[ai][0][m][1]), pack8(acc[ai][1][m][0], acc[ai][1][m][1]), lo, dry);
                    st2_f32<true>(f0 + cw + (lo ? 0 : 4), 8 * 2048, acc[ai][0][m][0], acc[ai][0][m][1], lo, dry); st2_f32<true>(f0 + cw + 32 + (lo ? 0 : 4), 8 * 2048, acc[ai][1][m][0], acc[ai][1][m][1], lo, dry);
                } else {
                    st2_bf16(GA + ro0 + cw + (lo ? 0 : 32), 8 * 2048, pack8(silu4(acc[ai][0][m][0]), silu4(acc[ai][0][m][1])), pack8(silu4(acc[ai][1][m][0]), silu4(acc[ai][1][m][1])), lo, dry);
                }
            }
    }
};
struct EpiBIn {
    static constexpr bool PERM = false, AFTER_DRAIN = false;
    bf16_t *QB, *KB, *VB, *QI, *KI, *GB; float* WI; float *okp, *oks, *ovp, *ovs, *oip, *ois; const float *tab64, *tab128; float qscale;
    int xskip = 0;
    __device__ __forceinline__ void operator()(const f32x4 (&acc)[2][2][4][2], const Unit& u, int wr, int wc, int fr, int fq) const { if (MK_EXPG == 5 && xskip) return;
        const int T = u.pn;
#pragma unroll
        for (int ai = 0; ai < 2; ++ai)
#pragma unroll
            for (int m = 0; m < 4; ++m) {
                const int row = u.pm * BM + ai * HALF + wr * 64 + m * 16 + fr; const bool pr = row < 8192; const int rs = row - 8192; const int pidx = pos_index_(row);
                if (T < 10) {
                    const int i64 = 16 * wc + 4 * fq; const float* tp = tab128 + ((size_t)pidx * 64 + i64) * 2; const f32x4 csa = *(const f32x4*)tp, csb = *(const f32x4*)(tp + 4);
#pragma unroll
                    for (int bj = 0; bj < 2; ++bj) { f32x4 o1, o2; rope4(acc[ai][bj][m][0], acc[ai][bj][m][1], csa, csb, o1, o2);
                        if (T < 8) { const int col = T * 256 + bj * HALF + i64; o1 = o1 * qscale; o2 = o2 * qscale; *(u32x2*)(QB + (size_t)row * 2048 + col) = pack4(o1); *(u32x2*)(QB + (size_t)row * 2048 + col + 64) = pack4(o2); }
                        else { const int col = (T - 8) * 256 + bj * HALF + i64; *(u32x2*)(KB + (size_t)row * 512 + col) = pack4(o1); *(u32x2*)(KB + (size_t)row * 512 + col + 64) = pack4(o2);
                            float* f = pr ? okp + (size_t)row * 512 : oks + (size_t)rs * 512; *(f32x4*)(f + col) = o1; *(f32x4*)(f + col + 64) = o2; } }
                } else if (T < 12) {
                    const int cw = (T - 10) * 256 + 64 * wc + 8 * fq; const bool lo = fr < 8; const int row0 = row - fr + (fr & 7); float* f0 = pr ? ovp + (size_t)row0 * 512 : ovs + (size_t)(row0 - 8192) * 512;
                    st2_bf16(VB + (size_t)row0 * 512 + cw + (lo ? 0 : 32), 8 * 512, pack8(acc[ai][0][m][0], acc[ai][0][m][1]), pack8(acc[ai][1][m][0], acc[ai][1][m][1]), lo);
                    st2_f32<false>(f0 + cw + (lo ? 0 : 4), 8 * 512, acc[ai][0][m][0], acc[ai][0][m][1], lo); st2_f32<false>(f0 + cw + 32 + (lo ? 0 : 4), 8 * 512, acc[ai][1][m][0], acc[ai][1][m][1], lo);
                } else if (T < 16) {
                    const int cw = (T - 12) * 256 + 64 * wc + 8 * fq; const bool lo = fr < 8; const int row0 = row - fr + (fr & 7);
                    f32x4 a1, a2, b1, b2; rope8(tab64, row, fq, acc[ai][0][m][0], acc[ai][1][m][0], acc[ai][0][m][1], acc[ai][1][m][1], a1, a2, b1, b2);
                    st2_bf16(QI + (size_t)row0 * 1024 + cw + (lo ? 0 : 32), 8 * 1024, pack8(a1, b1), pack8(a2, b2), lo);
                } else if (T == 16) {
                    if (wc < 2) { const int i32 = 16 * (wc & 1) + 4 * fq; const float* tp = tab64 + ((size_t)pidx * 32 + i32) * 2; const f32x4 csa = *(const f32x4*)tp, csb = *(const f32x4*)(tp + 4);
                        f32x4 o1, o2; rope4(acc[ai][0][m][0], acc[ai][0][m][1], csa, csb, o1, o2);
                        *(u32x2*)(KI + (size_t)row * 64 + i32) = pack4(o1); *(u32x2*)(KI + (size_t)row * 64 + i32 + 32) = pack4(o2);
                        float* f = pr ? oip + (size_t)row * 64 : ois + (size_t)rs * 64; *(f32x4*)(f + i32) = o1; *(f32x4*)(f + i32 + 32) = o2; }
                    else if (wc == 2) { *(f32x4*)(WI + (size_t)row * 16 + 4 * fq) = acc[ai][0][m][0] * 0.25f; }
                } else {
                    const int cw = (T - 17) * 256 + 64 * wc + 8 * fq; const bool lo = fr < 8; const int row0 = row - fr + (fr & 7);
                    st2_bf16(GB + (size_t)row0 * 2048 + cw + (lo ? 0 : 32), 8 * 2048, pack8(silu4(acc[ai][0][m][0]), silu4(acc[ai][0][m][1])), pack8(silu4(acc[ai][1][m][0]), silu4(acc[ai][1][m][1])), lo);
                }
            }
    }
};
__device__ __forceinline__ float tanh_fast(float x) { const float e = __expf(2.f * x); return 1.f - 2.f * __builtin_amdgcn_rcpf(e + 1.f); }
struct EpiC1 {
    static constexpr bool PERM = false, AFTER_DRAIN = false;
    float* RKVG; bf16_t* XL; size_t md;
    int xskip = 0;
    __device__ __forceinline__ void operator()(const f32x4 (&acc)[2][2][4][2], const Unit& u, int wr, int wc, int fr, int fq) const { if (MK_EXPG == 5 && xskip) return;
        const int pn = u.pn, pmt = u.pm % 34;
#pragma unroll
        for (int ai = 0; ai < 2; ++ai)
#pragma unroll
            for (int m = 0; m < 4; ++m) {
                const int row = pmt * BM + ai * HALF + wr * 64 + m * 16 + fr;
                if (pn < 32) { const bool lo = fr < 8; float* dst = RKVG + (size_t)(pn >> 3) * md + (size_t)(row - fr + (fr & 7)) * 2048 + (pn & 7) * 256 + 32 * wc + (lo ? 0 : 16) + 4 * fq;
#pragma unroll
                    for (int bj = 0; bj < 2; ++bj) { f32x4 s1, s2; rowpair(acc[ai][bj][m][0], acc[ai][bj][m][1], lo, s1, s2);
                        __builtin_nontemporal_store(s1, (f32x4*)(dst + bj * HALF)); __builtin_nontemporal_store(s2, (f32x4*)(dst + bj * HALF + 8 * 2048)); }
                } else {
#pragma unroll
                    for (int n = 0; n < 2; ++n) { f32x4 v = acc[ai][0][m][n]; if (pn == 32) v = (f32x4){tanh_fast(v[0]), tanh_fast(v[1]), tanh_fast(v[2]), tanh_fast(v[3])};
                        *(u32x2*)(XL + (size_t)row * 256 + (pn - 32) * 128 + 32 * wc + 16 * n + 4 * fq) = pack4(v); }
                }
            }
    }
};
struct EpiC2 {
    static constexpr bool PERM = false, AFTER_DRAIN = false;
    float *DEC, *AS; const float *w0, *a0;
    int xskip = 0;
    __device__ __forceinline__ void operator()(const f32x4 (&acc)[2][2][4][2], const Unit& u, int wr, int wc, int fr, int fq) const { if (MK_EXPG == 5 && xskip) return;
        const int pn = u.pn; const bool isw = pn < 8; float* dst = isw ? DEC : AS; const float* bias = isw ? w0 : a0;
#pragma unroll
        for (int ai = 0; ai < 2; ++ai)
#pragma unroll
            for (int m = 0; m < 4; ++m) { const bool lo = fr < 8; const int row0 = u.pm * BM + ai * HALF + wr * 64 + m * 16 + (fr & 7); float* drow = dst + (size_t)row0 * 2048;
#pragma unroll
                for (int bj = 0; bj < 2; ++bj) { f32x4 sx[2]; rowpair(acc[ai][bj][m][0], acc[ai][bj][m][1], lo, sx[0], sx[1]);
                    const int col = (pn & 7) * 256 + bj * HALF + 32 * wc + (lo ? 0 : 16) + 4 * fq; const f32x4 bb = *(const f32x4*)(bias + col);
#pragma unroll
                    for (int h = 0; h < 2; ++h) { const f32x4 x = sx[h] + bb; f32x4 o;
#pragma unroll
                        for (int e = 0; e < 4; ++e) { const float sg = __builtin_amdgcn_rcpf(1.f + __expf(-x[e])); o[e] = isw ? __expf(-0.6065306597126334f * sg) : sg; }
                        __builtin_nontemporal_store(o, (f32x4*)(drow + (size_t)h * 8 * 2048 + col)); } }
                asm volatile("" ::: "memory"); }
    }
};
struct EpiOut {
    static constexpr bool PERM = false, AFTER_DRAIN = false;
    const float* xp; float* XR; float* PART;
    int xskip = 0;
    __device__ __forceinline__ void operator()(const f32x4 (&acc)[2][2][4][2], const Unit& u, int wr, int wc, int fr, int fq) const { if (MK_EXPG == 5 && xskip) return;
        const bool samp = u.pm >= 32; float* pbase = PART + (size_t)(u.k0 >> 8) * 512 * 2048;
#pragma unroll
        for (int ai = 0; ai < 2; ++ai)
#pragma unroll
            for (int m = 0; m < 4; ++m) { const bool lo = fr < 8; const int row = u.pm * BM + ai * HALF + wr * 64 + m * 16 + (fr & 7); const float* b = xp + (size_t)row * 2048; float* o = samp ? pbase + (size_t)(row - 8192) * 2048 : XR + (size_t)row * 2048;
#pragma unroll
                for (int bj = 0; bj < 2; ++bj) { f32x4 s1, s2; rowpair(acc[ai][bj][m][0], acc[ai][bj][m][1], lo, s1, s2); const int col = u.pn * BM + bj * HALF + 32 * wc + (lo ? 0 : 16) + 4 * fq;
                    if (!samp) { s1 = s1 + *(const f32x4*)(b + col); s2 = s2 + *(const f32x4*)(b + 8 * 2048 + col); } *(f32x4*)(o + col) = s1; *(f32x4*)(o + 8 * 2048 + col) = s2; } }
    }
};
struct OutOrder {
    StaticOrder S; int G, c;
    __device__ __forceinline__ void init(int G_, int c_) { S.init(8192, 2048, G_, c_); G = G_; c = c_; }
    __device__ __forceinline__ bool next(int i, Unit& u) const { const int L = i * G + c; if (L < 256) return S.next(i, u); const int it = L - 256; if (it >= 128) return false;
        u.pm = 32 + (it >> 6); u.pn = (it >> 3) & 7; u.k0 = (it & 7) * 256; u.nt = 4; return true; }
    __device__ __forceinline__ void a_ready(const Unit&) const {}
    __device__ __forceinline__ void done(const Unit&) const {}
};
struct COrder {
    int G, c;
    __device__ __forceinline__ bool next(int i, Unit& u) const { const int L = i * G + c; if (L >= 34 * 34) return false; const int pn = L / 34, pmt = L % 34; const int nl = pn < 32 ? (pn >> 3) : (pn - 28); u.pm = nl * 34 + pmt; u.pn = pn; return true; }
    __device__ __forceinline__ void a_ready(const Unit&) const {}
    __device__ __forceinline__ void done(const Unit&) const {}
};
}
#define XB_TMO      128
#define XB_XCNT(j)  (256  + 64 * (j))
#define XB_XSUB(j)  (1280 + 64 * (j))
#define XB_XGEN(j)  (2304 + 64 * (j))
#define XB_TOP      3328
#define XB_TOPGEN   3392
#define XCD_BAR_WORDS 3456
#define XB_SPIN_CAP (1u << 18)

__device__ __forceinline__ unsigned xb_ld(unsigned* p)              { return __hip_atomic_load(p, __ATOMIC_RELAXED, __HIP_MEMORY_SCOPE_AGENT); }
__device__ __forceinline__ unsigned xb_add(unsigned* p, unsigned v) { return __hip_atomic_fetch_add(p, v, __ATOMIC_RELAXED, __HIP_MEMORY_SCOPE_AGENT); }
__device__ __forceinline__ unsigned xb_xcc_id() { return (unsigned)__builtin_amdgcn_s_getreg((3 << 11) | 20) & 0xFu; }
#define XB_SPIN(cond, bar) do { unsigned _sp = 0; while (cond) { __builtin_amdgcn_s_sleep(1); \
    if ((++_sp & 255u) == 0u) { if (xb_ld(&(bar)[XB_TMO])) break; if (_sp > XB_SPIN_CAP) { atomicAdd(&(bar)[XB_TMO], 1u); break; } } } } while (0)

struct XcdBarrier {
    unsigned* bar; unsigned x;
    volatile LAS unsigned* st;
};

__device__ __forceinline__ XcdBarrier xcd_barrier_post(unsigned* bar, volatile LAS unsigned* st) {
    XcdBarrier b; b.bar = bar; b.x = xb_xcc_id(); b.st = st;
    if (threadIdx.x == 0) (void)xb_add(&bar[XB_XCNT(b.x)], 1u);
    return b;
}
__device__ __forceinline__ void xcd_barrier_complete(unsigned* bar, unsigned x, unsigned& nloc, unsigned& nx) {
    const unsigned G = gridDim.x * gridDim.y * gridDim.z;
    unsigned sum, cnt, mine, sp = 0u;
    for (;;) {
        sum = 0u; cnt = 0u; mine = 0u;
#pragma unroll
        for (unsigned j = 0; j < 16; ++j) { const unsigned c = xb_ld(&bar[XB_XCNT(j)]); sum += c; cnt += (c > 0u) ? 1u : 0u; mine = (j == x) ? c : mine; }
        if (sum == G) break;
        __builtin_amdgcn_s_sleep(1);
        if ((++sp & 255u) == 0u) { if (xb_ld(&bar[XB_TMO])) break; if (sp > XB_SPIN_CAP) { atomicAdd(&bar[XB_TMO], 1u); break; } }
    }
    nloc = mine > 0u ? mine : 1u; nx = cnt > 0u ? cnt : 1u;
}

__device__ __forceinline__ void xcd_barrier(const XcdBarrier& b) {
    asm volatile("s_waitcnt vmcnt(0)" ::: "memory");
    __syncthreads();
    if (threadIdx.x == 0) {
        unsigned* bar = b.bar;
        __builtin_amdgcn_s_waitcnt(0);
        unsigned nloc = b.st[0], nx = b.st[1];
        if (nloc == 0u) { xcd_barrier_complete(bar, b.x, nloc, nx); b.st[0] = nloc; b.st[1] = nx; }
        const unsigned old = xb_add(&bar[XB_XSUB(b.x)], 1u);
        const unsigned gen = old / nloc;
        if (old + 1u == (gen + 1u) * nloc) {
            __builtin_amdgcn_fence(__ATOMIC_RELEASE, "agent");
            asm volatile("s_waitcnt vmcnt(0)" ::: "memory");
            const unsigned og = xb_add(&bar[XB_TOP], 1u);
            const unsigned tg = og / nx;
            if (og + 1u == (tg + 1u) * nx) xb_add(&bar[XB_TOPGEN], 1u);
            else XB_SPIN(xb_ld(&bar[XB_TOPGEN]) == tg, bar);
            __builtin_amdgcn_fence(__ATOMIC_ACQUIRE, "agent");
            xb_add(&bar[XB_XGEN(b.x)], 1u);
            asm volatile("s_waitcnt vmcnt(0)" ::: "memory");
        } else {
            XB_SPIN(xb_ld(&bar[XB_XGEN(b.x)]) == gen, bar);
            __builtin_amdgcn_fence(__ATOMIC_ACQUIRE, "agent");
            asm volatile("s_waitcnt vmcnt(0)" ::: "memory");
        }
    }
    __syncthreads();
}
constexpr int KSTR = 256, VSTR = 256, KBUF = 64 * KSTR, VBUF = 64 * VSTR, STAGEB = KBUF + VBUF;
__device__ __forceinline__ int kswz(int r) { return r & 15; }
__device__ __forceinline__ int vswz(int r) { return ((r & 3) << 2) | ((r >> 2) & 3); }
static_assert(4 * STAGEB <= RING_BYTES && 4 * 64 * 64 * 4 <= RING_BYTES, "attention LDS");
typedef short v4i16_t __attribute__((ext_vector_type(4)));
__device__ __forceinline__ s16x4 vtr(const LAS char* p) { return __builtin_bit_cast(s16x4, __builtin_amdgcn_ds_read_tr16_b64_v4i16((LAS v4i16_t*)p)); }
__device__ __forceinline__ int crow(int r, int hi) { return (r & 3) + 8 * (r >> 2) + 4 * hi; }

struct TileSrc { const char* k; const char* v; int ldb; int f32; };
template <class T> __device__ __forceinline__ T gld(const char* ubase, unsigned off) { return *(const GAS T*)((const GAS char*)ubase + off); }
__device__ __forceinline__ void half_load(const TileSrc& s, int which, int tid, v4u (&raw)[4]) {
    const char* base = which ? s.v : s.k; asm volatile("" : "+v"(tid));
#pragma unroll
    for (int i = 0; i < 2; ++i) { const unsigned p = tid + 512 * i, row = p >> 4, cg = p & 15;
        if (s.f32) { const unsigned o = row * (unsigned)s.ldb + cg * 32u; raw[2 * i] = gld<v4u>(base, o); raw[2 * i + 1] = gld<v4u>(base, o + 16u); }
        else raw[2 * i] = gld<v4u>(base, row * (unsigned)s.ldb + cg * 16u); }
}
__device__ __forceinline__ float u2f(unsigned u) { return __builtin_bit_cast(float, u); }
__device__ __forceinline__ v4u cvt8(const v4u a, const v4u b) { v4u o; o.x = cvtpk(u2f(a.x), u2f(a.y)); o.y = cvtpk(u2f(a.z), u2f(a.w)); o.z = cvtpk(u2f(b.x), u2f(b.y)); o.w = cvtpk(u2f(b.z), u2f(b.w)); return o; }
__device__ __forceinline__ void half_store(LAS unsigned char* buf, int which, int f32, int tid, const v4u (&raw)[4]) {
    asm volatile("" : "+v"(tid));
#pragma unroll
    for (int i = 0; i < 2; ++i) { const int p = tid + 512 * i, row = p >> 4, cg = p & 15;
        const v4u x = f32 ? cvt8(raw[2 * i], raw[2 * i + 1]) : raw[2 * i];
        if (which) *(LAS v4u*)(buf + KBUF + row * VSTR + ((cg ^ vswz(row)) << 4)) = x; else *(LAS v4u*)(buf + row * KSTR + ((cg ^ kswz(row)) << 4)) = x; }
}

struct AttnUnit {
    int qrow0;
    int ntiles;
    int samp, b, head;
    int qb;
    int dual, head2;
    int cv;
    int t0, split;
};

template <int LAYER>
__device__ __forceinline__ TileSrc tile_src(const Frame& F, const AttnUnit& u, int t, int j) {
    TileSrc s;
    if (LAYER == 0) {
        const bf16* KA = (const bf16*)(F.ws + WS_KA); const bf16* VA = (const bf16*)(F.ws + WS_VA);
        if (!u.samp) { const size_t o = ((size_t)(u.b * TP + 64 * t) * D + u.head * 128) * 2; s.k = (const char*)KA + o; s.v = (const char*)VA + o; s.ldb = D * 2; s.f32 = 0; }
        else if (t < 64 && u.cv) { const size_t o = ((((size_t)u.b * PAST + 64 * t) * 16 + u.head) * 128) * 2; s.k = (const char*)(F.ws + WS_KC) + o; s.v = (const char*)(F.ws + WS_VC) + o; s.ldb = D * 2; s.f32 = 0; }
        else if (t < 64) { const size_t o = ((((size_t)(j * 8 + u.b) * PAST + 64 * t) * 16 + u.head) * 128) * 4; s.k = (const char*)F.a->in[2] + o; s.v = (const char*)F.a->in[3] + o; s.ldb = D * 4; s.f32 = 1; }
        else { const size_t o = ((size_t)(NP + u.b * TS) * D + u.head * 128) * 2; s.k = (const char*)KA + o; s.v = (const char*)VA + o; s.ldb = D * 2; s.f32 = 0; }
    } else {
        const bf16* KB = (const bf16*)(F.ws + WS_KB); const bf16* VB = (const bf16*)(F.ws + WS_VB);
        if (!u.samp) { const size_t o = ((size_t)(u.b * TP + 64 * t) * 512 + u.head * 128) * 2; s.k = (const char*)KB + o; s.v = (const char*)VB + o; s.ldb = 512 * 2; s.f32 = 0; }
        else if (t < 64) { const size_t o = ((((size_t)u.b * PAST + 64 * t) * 4 + u.head) * 128) * 4; s.k = (const char*)F.a->in[4] + o; s.v = (const char*)F.a->in[5] + o; s.ldb = 512 * 4; s.f32 = 1; }
        else { const size_t o = ((size_t)(NP + u.b * TS) * 512 + u.head * 128) * 2; s.k = (const char*)KB + o; s.v = (const char*)VB + o; s.ldb = 512 * 2; s.f32 = 0; }
    }
    return s;
}

constexpr int MSKB = 512, STG2 = 2 * STAGEB + 2 * MSKB;
static_assert(2 * STG2 <= MISC_OFF, "attention DMA stages");
#ifndef MK_EXP
#define MK_EXP 0
#endif
#ifndef MK_EXPS
#define MK_EXPS 0
#endif
template <int LAYER, bool DMA>
__device__ __forceinline__ void attn_unit(Frame& F, const AttnUnit& u, int j, float lam, float lam_init, int xmode = 0) {
    constexpr int NKS = LAYER == 0 ? 4 : 8;
    int tid = F.tid; asm volatile("" : "+v"(tid));
    const int lane = tid & 63, w = F.wave, r32 = lane & 31, hi = lane >> 5, L = lane & 15;
    const int map = LAYER == 0 ? (w >> 2) : 0, sb = LAYER == 0 ? (w & 3) : (w >> 2), r4 = w & 3;
    const bool dual = LAYER == 0 && u.dual; const int hsel = dual ? (sb >> 1) : 0, sbr = dual ? (sb & 1) : sb, myhead = hsel ? u.head2 : u.head;
    const bool active = LAYER == 0 ? (u.samp ? (dual || sb < 2) : true) : true;
    const int my_last = LAYER == 0 ? (u.samp ? 64 : 2 * u.qb + (sb >> 1)) : u.ntiles - 1;
    const int qrow = u.qrow0 + 32 * sbr + r32;
    const int hcol = LAYER == 0 ? myhead * 128 : (u.head * 4 + r4) * 128;
    const int koff = LAYER == 0 ? map * 64 : 0;
    bf16x8 qf[NKS];
    { const bf16* Q = (const bf16*)(F.ws + (LAYER == 0 ? WS_QA : WS_QB)) + (size_t)(active ? qrow : u.qrow0) * D + hcol + koff + 8 * hi;
#pragma unroll
      for (int ks = 0; ks < NKS; ++ks) qf[ks] = *(const GAS bf16x8*)(Q + 16 * ks); }
    const char* mbase = (const char*)(F.ws + WS_MASK); const unsigned moff = (unsigned)qrow * (MASKW * 4u);
    f32x16 o[4];
#pragma unroll
    for (int d = 0; d < 4; ++d)
#pragma unroll
        for (int r = 0; r < 16; ++r) o[d][r] = 0.f;
    float mrun = -1e30f, lrun = 0.f;
    LAS unsigned char* lds = F.lds;
    const int Lq = L >> 2, vlane = (4 * hi + Lq) * VSTR + 8 * (L & 1);
    int voff[4][2];
#pragma unroll
    for (int d = 0; d < 4; ++d)
#pragma unroll
        for (int jj = 0; jj < 2; ++jj) voff[d][jj] = ((((d ^ Lq) << 2) | ((2 * ((lane >> 4) & 1) + ((L & 3) >> 1)) ^ (2 * jj + hi))) << 4);
    const int ksw = r32 & 15;
    v4u raw[4];
    const int T0 = u.t0;
    const LAS unsigned char* vb = nullptr;
#define ATT_VREAD(dst, q_) do { const LAS char* vp_ = (const LAS char*)vb + (((q_) >> 1) * 32 + 16 * ((q_) & 1)) * VSTR; \
        _Pragma("unroll") for (int d_ = 0; d_ < 4; ++d_) { dst[d_][0] = vtr(vp_ + voff[d_][0]); dst[d_][1] = vtr(vp_ + 8 * VSTR + voff[d_][1]); } } while (0)
#define ATT_PV(src, pb_, q_) do { _Pragma("unroll") for (int d_ = 0; d_ < 4; ++d_) { const s16x4 lo_ = src[d_][0], hh_ = src[d_][1]; \
        const bf16x8 vf_ = (bf16x8){lo_[0], lo_[1], lo_[2], lo_[3], hh_[0], hh_[1], hh_[2], hh_[3]}; o[d_] = __builtin_amdgcn_mfma_f32_32x32x16_bf16(vf_, pb_[(q_) >> 1][(q_) & 1], o[d_], 0, 0, 0); } } while (0)
    auto QK = [&](const LAS unsigned char* sbase, f32x16& s0, f32x16& s1) {
        const LAS unsigned char* kb = sbase + r32 * KSTR; const int kc0 = (koff >> 3) + hi;
#pragma unroll
        for (int r = 0; r < 16; ++r) { s0[r] = 0.f; s1[r] = 0.f; }
#pragma unroll
        for (int kh = 0; kh < NKS; kh += 4) {
            bf16x8 ka[4][2];
#pragma unroll
            for (int ks = 0; ks < 4; ++ks) { const int ko = ((kc0 + 2 * (kh + ks)) ^ ksw) << 4; ka[ks][0] = *(const LAS bf16x8*)(kb + ko); ka[ks][1] = *(const LAS bf16x8*)(kb + 32 * KSTR + ko); }
            __builtin_amdgcn_s_setprio(1);
#pragma unroll
            for (int ks = 0; ks < 4; ++ks) { s0 = __builtin_amdgcn_mfma_f32_32x32x16_bf16(ka[ks][0], qf[kh + ks], s0, 0, 0, 0); s1 = __builtin_amdgcn_mfma_f32_32x32x16_bf16(ka[ks][1], qf[kh + ks], s1, 0, 0, 0); }
            __builtin_amdgcn_s_setprio(0);
        }
    };
    auto SM = [&](unsigned w0, unsigned w1, f32x16& s0, f32x16& s1, bf16x8 (&pb)[2][2]) {
        if (LAYER == 1) {
#pragma unroll
            for (int r = 0; r < 16; ++r) { const int kv = crow(r, hi); if (!((w0 >> kv) & 1u)) s0[r] = -1e30f; if (!((w1 >> kv) & 1u)) s1[r] = -1e30f; } }
        float mx = fmaxf(s0[0], s1[0]);
#pragma unroll
        for (int r = 1; r < 16; ++r) mx = fmaxf(mx, fmaxf(s0[r], s1[r]));
        mx = fmaxf(mx, __shfl_xor(mx, 32));
        const bool need = mx > mrun + 8.f;
        if (__any(need)) { const float mnew = need ? mx : mrun, alpha = __builtin_amdgcn_exp2f(mrun - mnew); mrun = mnew; lrun *= alpha;
#pragma unroll
            for (int d = 0; d < 4; ++d)
#pragma unroll
                for (int r = 0; r < 16; ++r) o[d][r] *= alpha; }
        float rsa[4] = {0.f, 0.f, 0.f, 0.f};
#pragma unroll
        for (int r = 0; r < 16; ++r) { float p0 = __builtin_amdgcn_exp2f(s0[r] - mrun), p1 = __builtin_amdgcn_exp2f(s1[r] - mrun);
            if (LAYER == 1) { const int kv = crow(r, hi); p0 = ((w0 >> kv) & 1u) ? p0 : 0.f; p1 = ((w1 >> kv) & 1u) ? p1 : 0.f; }
            s0[r] = p0; s1[r] = p1; rsa[r & 3] += p0 + p1; }
        lrun += (rsa[0] + rsa[1]) + (rsa[2] + rsa[3]);
#pragma unroll
        for (int s = 0; s < 2; ++s) {
            v4u x; x.x = cvtpk(s0[8 * s + 0], s0[8 * s + 1]); x.y = cvtpk(s0[8 * s + 2], s0[8 * s + 3]); x.z = cvtpk(s0[8 * s + 4], s0[8 * s + 5]); x.w = cvtpk(s0[8 * s + 6], s0[8 * s + 7]); pb[0][s] = __builtin_bit_cast(bf16x8, x);
            v4u y; y.x = cvtpk(s1[8 * s + 0], s1[8 * s + 1]); y.y = cvtpk(s1[8 * s + 2], s1[8 * s + 3]); y.z = cvtpk(s1[8 * s + 4], s1[8 * s + 5]); y.w = cvtpk(s1[8 * s + 6], s1[8 * s + 7]); pb[1][s] = __builtin_bit_cast(bf16x8, y); }
    };
    AttnUnit u2 = u; u2.head = u.head2;
    if constexpr (DMA) {
#define ATT_ISSUE1(un_, t_, sb_) do { const TileSrc sd_ = tile_src<LAYER>(F, un_, (t_), j); \
        _Pragma("unroll") for (int i_ = 0; i_ < 2; ++i_) { const int ins_ = 2 * w + i_, row_ = 4 * ins_ + (lane >> 4), p_ = lane & 15; \
            __builtin_amdgcn_global_load_lds((const GAS unsigned*)(sd_.k + (size_t)row_ * sd_.ldb + ((p_ ^ kswz(row_)) << 4)), (LAS unsigned*)((sb_) + ins_ * 1024), 16, 0, 0); \
            __builtin_amdgcn_global_load_lds((const GAS unsigned*)(sd_.v + (size_t)row_ * sd_.ldb + ((p_ ^ vswz(row_)) << 4)), (LAS unsigned*)((sb_) + KBUF + ins_ * 1024), 16, 0, 0); } } while (0)
#define ATT_ISSUEM(t_, mb_) do { if (LAYER == 1 && w < 2) __builtin_amdgcn_global_load_lds((const GAS unsigned*)(mbase + (size_t)(u.qrow0 + 32 * w + (lane >> 1)) * (MASKW * 4) + (2 * (t_) + (lane & 1)) * 4), (LAS unsigned*)((mb_) + w * 256), 4, 0, 0); } while (0)
#define ATT_ISSUE2(p_, st_) do { LAS unsigned char* sp_ = lds + (st_) * STG2; const int ta_ = dual ? (p_) : 2 * (p_), tb_ = dual ? (p_) : 2 * (p_) + 1; ATT_ISSUE1(u, ta_, sp_); ATT_ISSUEM(ta_, sp_ + 2 * STAGEB); \
        if (dual || tb_ < u.ntiles) { ATT_ISSUE1(ub, tb_, sp_ + STAGEB); ATT_ISSUEM(tb_, sp_ + 2 * STAGEB + MSKB); } } while (0)
        const AttnUnit& ub = dual ? u2 : u;
        const int npairs = dual ? u.ntiles : (u.ntiles + 1) >> 1, p0 = dual ? T0 : T0 >> 1;
        ATT_ISSUE2(p0, p0 & 1);
        for (int p = p0; p < npairs; ++p) {
            asm volatile("s_waitcnt vmcnt(0)" ::: "memory");
            __builtin_amdgcn_s_barrier(); asm volatile("" ::: "memory");
            if (p + 1 < npairs) ATT_ISSUE2(p + 1, (p + 1) & 1);
            LAS unsigned char* const sa = lds + (p & 1) * STG2; LAS unsigned char* const sbb = sa + STAGEB;
            const int ta = dual ? p : 2 * p, tb = dual ? p : 2 * p + 1;
            const bool wka = active && !(dual && hsel) && ta <= my_last && !(xmode & 1), wkb = active && !(dual && !hsel) && tb < u.ntiles && tb <= my_last && !(xmode & 1);
            f32x16 a0, a1, b0, b1; bf16x8 pba[2][2], pbb[2][2]; s16x4 vpre[4][2], va[4][2], vbb[4][2];
            unsigned wa0 = 0xffffffffu, wa1 = 0xffffffffu, wb0 = 0xffffffffu, wb1 = 0xffffffffu;
            if (LAYER == 1) { const v2u ma = *(const LAS v2u*)(sa + 2 * STAGEB + (32 * sb + r32) * 8), mb = *(const LAS v2u*)(sa + 2 * STAGEB + MSKB + (32 * sb + r32) * 8); wa0 = ma.x; wa1 = ma.y; wb0 = mb.x; wb1 = mb.y; }
            if (wka) QK(sa, a0, a1);
            if (LAYER == 0) { if (wkb) QK(sbb, b0, b1); }
            if (wka) { vb = sa + KBUF + vlane; ATT_VREAD(vpre, 0); SM(wa0, wa1, a0, a1, pba);
                ATT_VREAD(va, 1); __builtin_amdgcn_s_setprio(1); ATT_PV(vpre, pba, 0); __builtin_amdgcn_s_setprio(0);
                ATT_VREAD(vbb, 2); __builtin_amdgcn_s_setprio(1); ATT_PV(va, pba, 1); __builtin_amdgcn_s_setprio(0);
                ATT_VREAD(va, 3); __builtin_amdgcn_s_setprio(1); ATT_PV(vbb, pba, 2); __builtin_amdgcn_s_setprio(0);
                __builtin_amdgcn_s_setprio(1); ATT_PV(va, pba, 3); __builtin_amdgcn_s_setprio(0); }
            if (LAYER == 1) { if (wkb) QK(sbb, b0, b1); }
            if (wkb) { vb = sbb + KBUF + vlane; ATT_VREAD(vpre, 0); SM(wb0, wb1, b0, b1, pbb);
                ATT_VREAD(va, 1); __builtin_amdgcn_s_setprio(1); ATT_PV(vpre, pbb, 0); __builtin_amdgcn_s_setprio(0);
                ATT_VREAD(vbb, 2); __builtin_amdgcn_s_setprio(1); ATT_PV(va, pbb, 1); __builtin_amdgcn_s_setprio(0);
                ATT_VREAD(va, 3); __builtin_amdgcn_s_setprio(1); ATT_PV(vbb, pbb, 2); __builtin_amdgcn_s_setprio(0);
                __builtin_amdgcn_s_setprio(1); ATT_PV(va, pbb, 3); __builtin_amdgcn_s_setprio(0); }
        }
#undef ATT_ISSUE1
#undef ATT_ISSUEM
#undef ATT_ISSUE2
        asm volatile("s_waitcnt lgkmcnt(0)" ::: "memory"); __builtin_amdgcn_s_barrier(); asm volatile("" ::: "memory");
    } else {
        const int SSTR = dual ? 2 * STAGEB : STAGEB; v4u raw2[4];
        { const TileSrc s0 = tile_src<LAYER>(F, u, T0, j); LAS unsigned char* fb = lds + (T0 & 1) * SSTR; half_load(s0, 0, tid, raw); half_store(fb, 0, s0.f32, tid, raw); half_load(s0, 1, tid, raw); half_store(fb, 1, s0.f32, tid, raw);
          if (dual) { const TileSrc s0b = tile_src<LAYER>(F, u2, T0, j); half_load(s0b, 0, tid, raw2); half_store(fb + STAGEB, 0, s0b.f32, tid, raw2); half_load(s0b, 1, tid, raw2); half_store(fb + STAGEB, 1, s0b.f32, tid, raw2); } }
        __syncthreads();
        for (int t = T0; t < u.ntiles; ++t) {
            const bool more = t + 1 < u.ntiles; TileSrc sn, snb; sn.f32 = 0; snb.f32 = 0;
            if (more) { sn = tile_src<LAYER>(F, u, t + 1, j); half_load(sn, 0, tid, raw); if (dual) { snb = tile_src<LAYER>(F, u2, t + 1, j); half_load(snb, 0, tid, raw2); } }
            LAS unsigned char* const sbase = lds + (t & 1) * SSTR + hsel * STAGEB; LAS unsigned char* const nb = lds + ((t + 1) & 1) * SSTR;
            const bool work = active && t <= my_last && !(xmode & 1);
            f32x16 s0, s1; bf16x8 pb[2][2];
            if (work) { QK(sbase, s0, s1); unsigned w0 = 0xffffffffu, w1 = 0xffffffffu; if (LAYER == 1) { const v2u mw = gld<v2u>(mbase, moff + 8u * t); w0 = mw.x; w1 = mw.y; } SM(w0, w1, s0, s1, pb); }
            if (more) { half_store(nb, 0, sn.f32, tid, raw); half_load(sn, 1, tid, raw); if (dual) { half_store(nb + STAGEB, 0, snb.f32, tid, raw2); half_load(snb, 1, tid, raw2); } }
            if (work) { vb = sbase + KBUF + vlane;
#pragma unroll
                for (int q = 0; q < 4; ++q) { s16x4 vcu[4][2]; ATT_VREAD(vcu, q); ATT_PV(vcu, pb, q); } }
            if (more) { half_store(nb, 1, sn.f32, tid, raw); if (dual) half_store(nb + STAGEB, 1, snb.f32, tid, raw2); }
            __syncthreads();
        }
    }
#undef ATT_VREAD
#undef ATT_PV
    const float ltot = lrun + __shfl_xor(lrun, 32);
    const float inv = active ? __builtin_amdgcn_rcpf(ltot) : 0.f;
    if (u.split >= 0) {
        if (active) { const int hd = LAYER == 0 ? myhead * 2 + map : u.head * 4 + r4;
            float* pr = (float*)(F.ws + WS_APART) + (((size_t)u.split * NS + (qrow - NP)) * 32 + hd) * 130;
#pragma unroll
            for (int d = 0; d < 4; ++d)
#pragma unroll
                for (int rg = 0; rg < 4; ++rg) { float* p = pr + d * 32 + 8 * rg + 4 * hi; p[0] = o[d][4 * rg]; p[1] = o[d][4 * rg + 1]; p[2] = o[d][4 * rg + 2]; p[3] = o[d][4 * rg + 3]; }
            if (hi == 0) { pr[128] = mrun; pr[129] = ltot; } }
        return;
    }
    bf16* OB = (bf16*)(F.ws + WS_OB);
    if (LAYER == 0) {
        LAS float* xch = (LAS float*)lds;
        if (map == 1 && active) { const float sc = inv * lam;
#pragma unroll
            for (int d = 0; d < 4; ++d)
#pragma unroll
                for (int r = 0; r < 16; ++r) xch[(sb * 64 + d * 16 + r) * 64 + lane] = o[d][r] * sc; }
        __syncthreads();
        if (map == 0 && active) {
            float ss = 0.f;
#pragma unroll
            for (int d = 0; d < 4; ++d)
#pragma unroll
                for (int r = 0; r < 16; ++r) { const float v = o[d][r] * inv - xch[(sb * 64 + d * 16 + r) * 64 + lane]; o[d][r] = v; ss += v * v; }
            ss += __shfl_xor(ss, 32);
            const float rsn = rsqrtf(ss * (1.f / 128.f) + 1e-5f) * (1.f - lam_init);
            const float* subg = F.a->in[14] + j * 128; const bf16* GA = (const bf16*)(F.ws + WS_GA) + (size_t)qrow * D + hcol; bf16* orow = OB + (size_t)qrow * D + hcol;
#pragma unroll
            for (int d = 0; d < 4; ++d)
#pragma unroll
                for (int rg = 0; rg < 4; ++rg) { const int dc = d * 32 + 8 * rg + 4 * hi; const f32x4 sg = *(const GAS f32x4*)(subg + dc); const v2u gg = *(const GAS v2u*)(GA + dc);
                    const float y0 = o[d][4 * rg + 0] * rsn * sg[0] * bf_lo(gg.x), y1 = o[d][4 * rg + 1] * rsn * sg[1] * bf_hi(gg.x), y2 = o[d][4 * rg + 2] * rsn * sg[2] * bf_lo(gg.y), y3 = o[d][4 * rg + 3] * rsn * sg[3] * bf_hi(gg.y);
                    v2u wv; wv.x = cvtpk(y0, y1); wv.y = cvtpk(y2, y3); *(GAS v2u*)(orow + dc) = wv; }
        }
        __syncthreads();
    } else {
        const bf16* GB = (const bf16*)(F.ws + WS_GB) + (size_t)qrow * D + hcol; bf16* orow = OB + (size_t)qrow * D + hcol;
#pragma unroll
        for (int d = 0; d < 4; ++d)
#pragma unroll
            for (int rg = 0; rg < 4; ++rg) { const int dc = d * 32 + 8 * rg + 4 * hi; const v2u gg = *(const GAS v2u*)(GB + dc);
                const float y0 = o[d][4 * rg + 0] * inv * bf_lo(gg.x), y1 = o[d][4 * rg + 1] * inv * bf_hi(gg.x), y2 = o[d][4 * rg + 2] * inv * bf_lo(gg.y), y3 = o[d][4 * rg + 3] * inv * bf_hi(gg.y);
                v2u wv; wv.x = cvtpk(y0, y1); wv.y = cvtpk(y2, y3); *(GAS v2u*)(orow + dc) = wv; }
    }
}

constexpr int CW_XRANK = 8192;
static_assert((CW_XRANK + 3 * 8 * 64) * 4 <= (int)CTL_ZERO_BYTES, "ctl rank words");
__device__ __forceinline__ int attn_slot(Frame& F, int phase_id) {
    unsigned* ctl = (unsigned*)(F.ws + WS_CTL); volatile LAS int* sh = (volatile LAS int*)(F.lds + MISC_OFF + 64);
    if (F.tid == 0) { int slot = F.bid;
        if (F.G == 256 && F.census != nullptr) { bool ok = true; for (int jx = 0; jx < 8; ++jx) ok = ok && (__hip_atomic_load(F.census + XB_XCNT(jx), __ATOMIC_RELAXED, __HIP_MEMORY_SCOPE_AGENT) == 32u);
            if (ok) { const unsigned x = xb_xcc_id() & 7u; const unsigned rk = __hip_atomic_fetch_add(ctl + CW_XRANK + (phase_id * 8 + (int)x) * 64, 1u, __ATOMIC_RELAXED, __HIP_MEMORY_SCOPE_AGENT); slot = (int)((rk & 31u) * 8u + x); } }
        sh[0] = slot; }
    __syncthreads(); const int r = sh[0]; __syncthreads(); return r;
}
constexpr int A_SPLITS = 4, B_SPLITS = 8;
__device__ __forceinline__ float lam_of(const Frame& F, int j, float lam_init) { const float* lp = F.a->in[13] + j * 256; float l0 = 0.f, l1 = 0.f;
    for (int i = 0; i < 64; ++i) { l0 += lp[i] * lp[64 + i]; l1 += lp[128 + i] * lp[192 + i]; } return __expf(l0) - __expf(l1) + lam_init; }
#ifndef MK_DUPSEL
#define MK_DUPSEL 0
#endif
__device__ __forceinline__ void p_attn_a(Frame& F, int j, float lam_init, int rep = 0) {
    const float lam = lam_of(F, j, lam_init); const int slot0 = attn_slot(F, j ? 2 : 0);
    const int cv = j;
    for (int slot = slot0; slot < 256; slot += F.G) {
        const int spos = ((slot & 7) * 5) >> 3;
        for (int it = 0; it < 5; ++it) { const int is = it == spos ? 0 : 2 + (it < spos ? it : it - 1);
            AttnUnit u; u.cv = cv; u.dual = 0; u.head2 = 0;
            if (is < 2) {
                const int bp = slot >> 2, sp = slot & 3; u.samp = 1; u.dual = 1; u.b = bp >> 3; u.head = 2 * (bp & 7); u.head2 = u.head + 1; u.qb = 0; u.qrow0 = NP + u.b * TS; u.t0 = 16 * sp; u.ntiles = sp == 3 ? 65 : 16 * sp + 16; u.split = sp; }
            else { const int r = is - 2, x = slot & 7, i = slot >> 3, k = i & 15, bh = x * 8 + 2 * r + (i >> 4);
                u.samp = 0; u.b = bh >> 4; u.head = bh & 15; u.qb = (r & 1) ? 15 - k : k; u.qrow0 = u.b * TP + u.qb * 128; u.ntiles = 2 * u.qb + 2; u.t0 = 0; u.split = -1; }
            if (u.samp && !cv) attn_unit<0, false>(F, u, j, lam, lam_init, 0); else attn_unit<0, true>(F, u, j, lam, lam_init, 0); }
    }
}
__device__ __forceinline__ void p_attn_b(Frame& F) {
    const int slot0 = attn_slot(F, 1);
    for (int slot = slot0; slot < 256; slot += F.G) {
        for (int part = 0; part < 2; ++part) { const bool do_sample = ((slot >> 3) & 1) ? (part == 1) : (part == 0);
            if (do_sample) { const int bg = slot >> 3, sp = slot & 7;
                AttnUnit u; u.cv = 0; u.dual = 0; u.head2 = 0; u.samp = 1; u.b = bg >> 2; u.head = bg & 3; u.qb = 0; u.qrow0 = NP + u.b * TS; u.t0 = 8 * sp; u.ntiles = sp == 7 ? 65 : 8 * sp + 8; u.split = sp; attn_unit<1, false>(F, u, 0, 0.f, 0.f); }
            else { const int x = slot & 7, i = slot >> 3;
                for (int r = 0; r < 2; ++r) { const int bg = 2 * x + r;
                    AttnUnit u; u.cv = 0; u.dual = 0; u.head2 = 0; u.samp = 0; u.b = bg >> 2; u.head = bg & 3; u.qb = r ? 31 - i : i; u.qrow0 = u.b * TP + u.qb * 64; u.ntiles = u.qb + 1; u.t0 = 0; u.split = -1; attn_unit<1, true>(F, u, 0, 0.f, 0.f); } }
        }
    }
}
template <int LAYER>
__device__ __forceinline__ void p_attn_combine(Frame& F, int j, float lam_init) {
    constexpr int NSPL = LAYER == 0 ? A_SPLITS : B_SPLITS;
    const float lam = LAYER == 0 ? lam_of(F, j, lam_init) : 0.f;
    const int gw = F.bid * NWAVES + F.wave, NGW = F.G * NWAVES, lane = F.lane;
    const float* PA = (const float*)(F.ws + WS_APART); bf16* OB = (bf16*)(F.ws + WS_OB);
    for (int it = gw; it < NS * 16; it += NGW) { const int r = it >> 4, h = it & 15, row = NP + r;
        f32x2 acc[2]; float lsum[2];
#pragma unroll
        for (int mp = 0; mp < (LAYER == 0 ? 2 : 1); ++mp) { const int hd = LAYER == 0 ? h * 2 + mp : h;
            float mm[NSPL], ll[NSPL]; f32x2 oo[NSPL]; float mx = -1e30f;
#pragma unroll
            for (int s = 0; s < NSPL; ++s) { const float* pr = PA + (((size_t)s * NS + r) * 32 + hd) * 130; oo[s] = *(const GAS f32x2*)(pr + 2 * lane); mm[s] = pr[128]; ll[s] = pr[129]; mx = fmaxf(mx, mm[s]); }
            f32x2 a = {0.f, 0.f}; float l = 0.f;
#pragma unroll
            for (int s = 0; s < NSPL; ++s) { const float f = __builtin_amdgcn_exp2f(mm[s] - mx); a = a + oo[s] * f; l += ll[s] * f; }
            acc[mp] = a; lsum[mp] = l; }
        f32x2 o;
        if (LAYER == 0) { o = acc[0] * __builtin_amdgcn_rcpf(lsum[0]) - acc[1] * (lam * __builtin_amdgcn_rcpf(lsum[1]));
            const float ss = wave_sum(o.x * o.x + o.y * o.y); const float rsn = rsqrtf(ss * (1.f / 128.f) + 1e-5f) * (1.f - lam_init);
            const f32x2 sg = *(const GAS f32x2*)(F.a->in[14] + j * 128 + 2 * lane); o = o * rsn * sg; }
        else o = acc[0] * __builtin_amdgcn_rcpf(lsum[0]);
        const unsigned gg = *(const GAS unsigned*)((const bf16*)(F.ws + (LAYER == 0 ? WS_GA : WS_GB)) + (size_t)row * D + h * 128 + 2 * lane);
        *(GAS unsigned*)(OB + (size_t)row * D + h * 128 + 2 * lane) = cvtpk(o.x * bf_lo(gg), o.y * bf_hi(gg)); }
}
constexpr int QISTR = 2064;
template <int CTRL> __device__ __forceinline__ int dppi(int x) { return __builtin_amdgcn_update_dpp(0, x, CTRL, 0xF, 0xF, true); }
__device__ __forceinline__ int wave_isum(int v) {
    v += dppi<0xB1>(v); v += dppi<0x4E>(v); v += dppi<0x141>(v); v += dppi<0x140>(v);
    return __builtin_amdgcn_readlane(v, 0) + __builtin_amdgcn_readlane(v, 16) + __builtin_amdgcn_readlane(v, 32) + __builtin_amdgcn_readlane(v, 48);
}
__device__ __forceinline__ unsigned tokey(float x) { x += 0.f; const unsigned u = __builtin_bit_cast(unsigned, x); return (u & 0x80000000u) ? ~u : (u | 0x80000000u); }
template <int NREG>
__device__ __forceinline__ void select_row(const float* sc, int nadm, unsigned* mrow, int lane) {
    unsigned key[NREG];
#pragma unroll
    for (int i = 0; i < NREG; ++i) { const int s = 64 * i + lane; key[i] = s < nadm ? tokey(__builtin_bit_cast(float, __hip_atomic_load((const unsigned*)sc + s, __ATOMIC_RELAXED, __HIP_MEMORY_SCOPE_AGENT))) : 0u; }
    unsigned T = 0u;
    for (int bit = 31; bit >= 0; --bit) { const unsigned cand = T | (1u << bit); int c4[4] = {0, 0, 0, 0};
#pragma unroll
        for (int i = 0; i < NREG; ++i) c4[i & 3] += key[i] >= cand ? 1 : 0;
        const int c = wave_isum((c4[0] + c4[1]) + (c4[2] + c4[3])); if (c >= 256) T = cand; }
    int cg = 0;
#pragma unroll
    for (int i = 0; i < NREG; ++i) cg += key[i] > T ? 1 : 0;
    cg = wave_isum(cg);
    const int need = 256 - cg; int run = 0; const unsigned long long lt = (1ull << lane) - 1ull;
#pragma unroll
    for (int i = 0; i < NREG; ++i) { if (64 * i < nadm) { const bool eq = key[i] == T; const unsigned long long be = __ballot(eq); const int rank = run + __popcll(be & lt);
            const bool sel = key[i] > T || (eq && rank < need); const unsigned long long bs = __ballot(sel);
            if (lane == 0) { mrow[2 * i] = (unsigned)bs; mrow[2 * i + 1] = (unsigned)(bs >> 32); } run += __popcll(be); } }
}
__device__ __forceinline__ void idx_unit(Frame& F, int samp, int b, int qb, int part = -1) {
    const int tid = F.tid, lane = F.lane, w = F.wave, r32 = lane & 31, hi = lane >> 5;
    const int row0 = samp ? NP + b * TS + 32 * qb : b * TP + 32 * qb;
    const int nadm = samp ? SALL : ((qb >> 1) + 1) * 64, nst = nadm / 32;
    LAS unsigned char* lds = F.lds; LAS float* wiT = (LAS float*)(lds + 32 * QISTR);
    const bf16* QI = (const bf16*)(F.ws + WS_QI); const bf16* KI = (const bf16*)(F.ws + WS_KI); const float* WI = (const float*)(F.ws + WS_WI);
    float* SC = (float*)(F.ws + WS_SC); const int scld = samp ? SALL : 2048; float* sc0 = samp ? SC + SC_S_OFF + (size_t)(row0 - NP) * SALL : SC + (size_t)row0 * 2048;
#pragma unroll
    for (int i = 0; i < 8; ++i) { const int p = tid + 512 * i, r = p >> 7, c = p & 127; *(LAS v4u*)(lds + r * QISTR + c * 16) = *(const GAS v4u*)(QI + (size_t)(row0 + r) * 1024 + c * 8); }
    wiT[(tid & 15) * 32 + (tid >> 4)] = WI[(size_t)(row0 + (tid >> 4)) * 16 + (tid & 15)];
    __syncthreads();
    const int st0 = part < 0 ? 0 : (part * nst) >> 2, st1 = part < 0 ? nst : ((part + 1) * nst) >> 2;
    for (int st = st0 + w; st < st1; st += NWAVES) {
        const int s = st * 32 + r32; bf16x8 kf[4];
        if (samp && s < PAST) { const float* kp = F.a->in[6] + ((size_t)b * PAST + s) * 64 + 8 * hi;
#pragma unroll
            for (int ks = 0; ks < 4; ++ks) { const v4u a = *(const GAS v4u*)(kp + 16 * ks), c = *(const GAS v4u*)(kp + 16 * ks + 4); kf[ks] = __builtin_bit_cast(bf16x8, cvt8(a, c)); } }
        else { const bf16* kp = KI + (size_t)(samp ? NP + b * TS + (s - PAST) : b * TP + s) * 64 + 8 * hi;
#pragma unroll
            for (int ks = 0; ks < 4; ++ks) kf[ks] = *(const GAS bf16x8*)(kp + 16 * ks); }
        f32x16 sc;
#pragma unroll
        for (int r = 0; r < 16; ++r) sc[r] = 0.f;
#pragma unroll 2
        for (int h = 0; h < 16; ++h) {
            f32x16 acc;
#pragma unroll
            for (int r = 0; r < 16; ++r) acc[r] = 0.f;
            const LAS unsigned char* qp = lds + r32 * QISTR + (h * 64 + 8 * hi) * 2;
#pragma unroll
            for (int ks = 0; ks < 4; ++ks) acc = __builtin_amdgcn_mfma_f32_32x32x16_bf16(*(const LAS bf16x8*)(qp + ks * 32), kf[ks], acc, 0, 0, 0);
#pragma unroll
            for (int rg = 0; rg < 4; ++rg) { const f32x4 wq = *(const LAS f32x4*)(wiT + h * 32 + 8 * rg + 4 * hi);
#pragma unroll
                for (int e = 0; e < 4; ++e) sc[4 * rg + e] += wq[e] * fmaxf(acc[4 * rg + e] * 0.125f, 0.f); }
        }
#pragma unroll
        for (int r = 0; r < 16; ++r) sc0[(size_t)crow(r, hi) * scld + s] = sc[r];
    }
    __syncthreads();
    unsigned* MASKp = (unsigned*)(F.ws + WS_MASK);
    (void)MASKp;
}
__device__ __forceinline__ void p_idx(Frame& F, int rep = 0) {
    for (int U = F.bid; U < (F.G == 256 ? 256 : 320); U += F.G) {
        if (U < 256) idx_unit(F, 0, U & 3, 63 - (U >> 2));
        else { const int v = U - 256; idx_unit(F, 1, (v >> 1) & 7, v & 1, v >> 4); }
    }
    if (F.G == 256 && F.bid >= 192) { const int v = 255 - F.bid; idx_unit(F, 1, (v >> 1) & 7, v & 1, v >> 4); }
}
__device__ __forceinline__ void p_idx_select(Frame& F) {
    const int gw = F.wave * F.G + F.bid, NGW = F.G * NWAVES, lane = F.lane;
    unsigned* MASKp = (unsigned*)(F.ws + WS_MASK); const float* SC = (const float*)(F.ws + WS_SC);
    for (int k = 0;; ++k) {
        int it;
        if (NGW == 2048) { if (gw < 512) { if (k > 4) break; it = k == 0 ? gw : NS + 6144 + 512 * (k - 1) + gw; } else { if (k > 3) break; it = NS + (gw - 512) + 1536 * k; } }
        else { it = gw + k * NGW; if (it >= M) break; }
        int row, nadm; const float* scr;
        if (it < NS) { row = NP + it; nadm = SALL; scr = SC + SC_S_OFF + (size_t)it * SALL; }
        else { const int q = it - NS, t = TP - 1 - (q >> 2), b = q & 3; row = b * TP + t; nadm = ((t >> 6) + 1) * 64; scr = SC + (size_t)row * 2048; }
        unsigned* mrow = MASKp + (size_t)row * MASKW;
        if (nadm <= 256) { if (lane < nadm / 32) mrow[lane] = 0xffffffffu; }
        else if (row >= NP) select_row<65>(scr, nadm, mrow, lane);
        else if (nadm <= 512) select_row<8>(scr, nadm, mrow, lane);
        else if (nadm <= 1024) select_row<16>(scr, nadm, mrow, lane);
        else if (nadm <= 1536) select_row<24>(scr, nadm, mrow, lane);
        else select_row<32>(scr, nadm, mrow, lane);
    }
}

constexpr int SC_BUF = 49152, SC_O = 98304, TC = 32;
template <int CTRL> __device__ __forceinline__ float dppf(float x) { return __builtin_bit_cast(float, __builtin_amdgcn_update_dpp(0, __builtin_bit_cast(int, x), CTRL, 0xF, 0xF, true)); }
#define DPP_X1 0xB1
#define DPP_X2 0x4E
#define DPP_HM 0x141
#define DPP_RM 0x140
__device__ __forceinline__ float red8(float v) { v += dppf<DPP_X1>(v); v += dppf<DPP_X2>(v); v += dppf<DPP_HM>(v); return v; }
__device__ __forceinline__ float red16(float v) { v = red8(v); v += dppf<DPP_RM>(v); return v; }
struct ScanRaw { f32x4 r, k, v, g, d, a; };
#ifndef MK_EXPC
#define MK_EXPC 0
#endif
__device__ __forceinline__ void scan_unit(Frame& F, int samp, int b, int h, int xmode = 0) {
    const int tid = F.tid, vp = (tid >> 3) & 31, kq = tid & 7, srow = tid >> 4, c4 = tid & 15;
    const int T = samp ? TS : TP, row0 = samp ? NP + b * TS : b * TP, nch = T / TC;
    LAS unsigned char* lds = F.lds;
    const float* Rg = (const float*)(F.ws + WS_R); const float* Kg = (const float*)(F.ws + WS_K); const float* Vg = (const float*)(F.ws + WS_V); const float* Gg = (const float*)(F.ws + WS_G);
    const float* Dg = (const float*)(F.ws + WS_DEC); const float* Ag = (const float*)(F.ws + WS_AS); bf16* OB = (bf16*)(F.ws + WS_OB);
    const int hc = h * 64 + 4 * c4;
    const f32x4 kk_w = *(const GAS f32x4*)(F.a->in[24] + hc), ka_w = *(const GAS f32x4*)(F.a->in[25] + hc), rk_w = *(const GAS f32x4*)(F.a->in[26] + hc), lnw = *(const GAS f32x4*)(F.a->in[27] + hc), lnb = *(const GAS f32x4*)(F.a->in[28] + hc);
    const bool scanner = F.wave < 4;
    f32x2 S[8];
    { const float* sp = F.a->in[7] + (((size_t)b * 32 + h) * 64 + 2 * vp) * 64 + 8 * kq; f32x4 a0 = {0.f, 0.f, 0.f, 0.f}, a1 = a0, c0 = a0, c1 = a0;
      if (samp && scanner) { a0 = *(const GAS f32x4*)sp; a1 = *(const GAS f32x4*)(sp + 4); c0 = *(const GAS f32x4*)(sp + 64); c1 = *(const GAS f32x4*)(sp + 68); }
#pragma unroll
      for (int i = 0; i < 4; ++i) { S[i] = (f32x2){a0[i], c0[i]}; S[4 + i] = (f32x2){a1[i], c1[i]}; } }
    ScanRaw raw; f32x4 cv, cg; float cbd;
#define SCAN_LOAD(ch) do { const size_t o_ = (size_t)(row0 + (ch) * TC + srow) * D + hc; raw.r = *(const GAS f32x4*)(Rg + o_); raw.k = *(const GAS f32x4*)(Kg + o_); raw.v = *(const GAS f32x4*)(Vg + o_); \
        raw.g = *(const GAS f32x4*)(Gg + o_); raw.d = *(const GAS f32x4*)(Dg + o_); raw.a = *(const GAS f32x4*)(Ag + o_); } while (0)
#define SCAN_STAGE(bi) do { LAS unsigned char* bp_ = lds + (bi) * SC_BUF + (srow * 64 + 4 * c4) * 4; \
        const f32x4 kkr_ = raw.k * kk_w; const float ss_ = red16((kkr_[0] * kkr_[0] + kkr_[1] * kkr_[1]) + (kkr_[2] * kkr_[2] + kkr_[3] * kkr_[3])); \
        const f32x4 kkn_ = kkr_ * (1.f / fmaxf(sqrtf(ss_), 1e-12f)); const f32x4 km_ = raw.k * (1.f + (raw.a - 1.f) * ka_w); const f32x4 rkr_ = raw.r * km_ * rk_w; \
        cbd = red16((rkr_[0] + rkr_[1]) + (rkr_[2] + rkr_[3])); cv = raw.v; cg = raw.g; \
        *(LAS f32x4*)(bp_) = raw.r; *(LAS f32x4*)(bp_ + 8192) = raw.d; *(LAS f32x4*)(bp_ + 16384) = km_; *(LAS f32x4*)(bp_ + 24576) = kkn_; *(LAS f32x4*)(bp_ + 32768) = kkn_ * raw.a; *(LAS f32x4*)(bp_ + 40960) = raw.v; } while (0)
    SCAN_LOAD(0); SCAN_STAGE(0);
    __syncthreads();
    LAS float* sO = (LAS float*)(lds + SC_O);
    for (int ch = 0; ch < nch; ++ch) {
        const bool more = ch + 1 < nch;
        const f32x4 ev = cv, eg = cg; const float ebd = cbd;
        if (more) SCAN_LOAD(ch + 1);
        if (scanner && !(xmode & 1)) {
            const LAS unsigned char* bp = lds + (ch & 1) * SC_BUF + kq * 32;
            const LAS unsigned char* vvp = lds + (ch & 1) * SC_BUF + 40960 + 8 * vp;
            struct StepV { f32x4 rr[2], ww[2], kx[2], qq[2], bb[2]; f32x2 vv; };
#define SCAN_FETCH(dst, t) do { const LAS unsigned char* tp_ = bp + (t) * 256; _Pragma("unroll") for (int hh = 0; hh < 2; ++hh) { dst.rr[hh] = *(const LAS f32x4*)(tp_ + 16 * hh); dst.ww[hh] = *(const LAS f32x4*)(tp_ + 8192 + 16 * hh); \
                dst.kx[hh] = *(const LAS f32x4*)(tp_ + 16384 + 16 * hh); dst.qq[hh] = *(const LAS f32x4*)(tp_ + 24576 + 16 * hh); dst.bb[hh] = *(const LAS f32x4*)(tp_ + 32768 + 16 * hh); } \
                dst.vv = *(const LAS f32x2*)(vvp + (t) * 256); } while (0)
            StepV cur; SCAN_FETCH(cur, 0);
            for (int t8 = 0; t8 < TC; t8 += 8) {
                f32x2 keep = {0.f, 0.f};
#pragma unroll
                for (int j = 0; j < 8; ++j) {
                    StepV nxt; { const int tn = (t8 + j + 1 < TC) ? t8 + j + 1 : t8 + j; SCAN_FETCH(nxt, tn); }
                    asm volatile("" ::: "memory");
                    f32x2 sa0 = S[0] * cur.qq[0][0] + S[1] * cur.qq[0][1], sa1 = S[2] * cur.qq[0][2] + S[3] * cur.qq[0][3], sa2 = S[4] * cur.qq[1][0] + S[5] * cur.qq[1][1], sa3 = S[6] * cur.qq[1][2] + S[7] * cur.qq[1][3];
                    f32x2 tt[8];
#pragma unroll
                    for (int i = 0; i < 8; ++i) tt[i] = S[i] * cur.ww[i >> 2][i & 3] + cur.vv * cur.kx[i >> 2][i & 3];
                    f32x2 sa = (sa0 + sa1) + (sa2 + sa3);
                    { float sx = sa.x, sy = sa.y; asm volatile("" : "+v"(sx)); asm volatile("" : "+v"(sy)); sx = red8(sx); asm volatile("" : "+v"(sx)); sy = red8(sy); sa.x = -sx; sa.y = -sy; }
#pragma unroll
                    for (int i = 0; i < 8; ++i) S[i] = tt[i] + sa * cur.bb[i >> 2][i & 3];
                    f32x2 oo = ((S[0] * cur.rr[0][0] + S[1] * cur.rr[0][1]) + (S[2] * cur.rr[0][2] + S[3] * cur.rr[0][3])) + ((S[4] * cur.rr[1][0] + S[5] * cur.rr[1][1]) + (S[6] * cur.rr[1][2] + S[7] * cur.rr[1][3]));
                    { float ox = oo.x, oy = oo.y; asm volatile("" : "+v"(ox)); asm volatile("" : "+v"(oy)); ox = red8(ox); asm volatile("" : "+v"(ox)); oy = red8(oy); oo.x = ox; oo.y = oy; }
                    if (kq == j) keep = oo;
                    cur = nxt;
                }
                *(LAS f32x2*)(sO + (t8 + kq) * 64 + 2 * vp) = keep;
            }
#undef SCAN_FETCH
        }
        __syncthreads();
        { const f32x4 o4 = *(const LAS f32x4*)(sO + srow * 64 + 4 * c4);
          const float mean = red16((o4[0] + o4[1]) + (o4[2] + o4[3])) * (1.f / 64.f); const f32x4 dl = o4 - mean;
          const float var = red16((dl[0] * dl[0] + dl[1] * dl[1]) + (dl[2] * dl[2] + dl[3] * dl[3])) * (1.f / 64.f); const float rstd = rsqrtf(var + 64e-5f);
          f32x4 y = dl * rstd * lnw + lnb + ev * ebd; y = (f32x4){y[0] * silu_f(eg[0]), y[1] * silu_f(eg[1]), y[2] * silu_f(eg[2]), y[3] * silu_f(eg[3])};
          v2u wv; wv.x = cvtpk(y[0], y[1]); wv.y = cvtpk(y[2], y[3]); *(GAS v2u*)(OB + (size_t)(row0 + ch * TC + srow) * D + hc) = wv; }
        if (more) SCAN_STAGE((ch + 1) & 1);
        __syncthreads();
    }
#undef SCAN_LOAD
#undef SCAN_STAGE
    if (scanner) { float* so = F.out + (samp ? O_CWS : O_CWP) + (((size_t)b * 32 + h) * 64 + 2 * vp) * 64 + 8 * kq;
      *(GAS f32x4*)so = (f32x4){S[0].x, S[1].x, S[2].x, S[3].x}; *(GAS f32x4*)(so + 4) = (f32x4){S[4].x, S[5].x, S[6].x, S[7].x};
      *(GAS f32x4*)(so + 64) = (f32x4){S[0].y, S[1].y, S[2].y, S[3].y}; *(GAS f32x4*)(so + 68) = (f32x4){S[4].y, S[5].y, S[6].y, S[7].y}; }
}
__device__ __forceinline__ void cache_conv(Frame& F, int rank, int nwg) {
    constexpr unsigned NV8 = 8u * PAST * D / 8u;
    int tid = F.tid; asm volatile("" : "+v"(tid));
    const unsigned stride = (unsigned)nwg * NTHR;
    for (int which = 0; which < 2; ++which) {
        const char* src = (const char*)(F.a->in[2 + which] + (size_t)8 * PAST * D); unsigned char* dst = F.ws + (which ? WS_VC : WS_KC);
        for (unsigned i = (unsigned)rank * NTHR + tid; i < NV8; i += 4u * stride) {
            v4u a[4][2];
#pragma unroll
            for (int q = 0; q < 4; ++q) { const unsigned idx = i + q * stride; if (idx < NV8) { a[q][0] = gld<v4u>(src, idx * 32u); a[q][1] = gld<v4u>(src, idx * 32u + 16u); } }
#pragma unroll
            for (int q = 0; q < 4; ++q) { const unsigned idx = i + q * stride; if (idx < NV8) *(GAS v4u*)((GAS unsigned char*)dst + idx * 16u) = cvt8(a[q][0], a[q][1]); }
        }
    }
}
__device__ __forceinline__ void p_scan(Frame& F, int rep = 0) {
    const int xm = (MK_EXPC && rep == 0) ? MK_EXPC : 0;
    for (int slot = F.bid; slot < 256; slot += F.G) {
        if (slot < 128) scan_unit(F, 0, slot >> 5, slot & 31, xm);
        else { const int su = slot - 128; scan_unit(F, 1, su >> 5, su & 31); scan_unit(F, 1, (su + 128) >> 5, (su + 128) & 31);
            __syncthreads(); conv_deferred(F, su, 128); if (!(MK_EXPC & 2) || rep == 1) cache_conv(F, su, 128); }
    }
}
constexpr int NPHASES = 23;

template <class Epi, class Sched>
__device__ __forceinline__ void run_gemm(Frame& F, const bf16* A, const bf16* Bt, int Mm, int Nn, int Kk, const Sched& S, const Epi& E) {
    pg8::Gemm g{A, Bt, Mm, Nn, Kk, Kk};
    pg8::gemm_phase<Epi, Sched, true, true>(F.lds, g, S, E);
}

__global__ void __launch_bounds__(NTHR, 2) mega(Args args) {
    extern __shared__ __attribute__((aligned(16))) unsigned char lds_raw[];
    Frame F;
    F.lds = (LAS unsigned char*)lds_raw;
    F.tid = threadIdx.x; F.lane = F.tid & 63; F.wave = __builtin_amdgcn_readfirstlane(F.tid >> 6); F.G = gridDim.x; F.bid = blockIdx.x;
    F.a = (const __attribute__((address_space(4))) Args*)__builtin_amdgcn_kernarg_segment_ptr(); F.out = args.out; F.ws = args.ws;
    volatile LAS unsigned* MISC = (volatile LAS unsigned*)(F.lds + MISC_OFF);
    for (int u = F.tid; u < (LDS_BYTES - RING_BYTES) / 4; u += NTHR) ((LAS unsigned*)(F.lds + RING_BYTES))[u] = 0u;
    __syncthreads();
    unsigned* ctl = (unsigned*)(F.ws + WS_CTL);
    const int lo = args.ph_lo, hi = args.ph_hi;
    XcdBarrier bar; bar.bar = ctl + CW_BAR + args.li * XCD_BAR_WORDS; bar.x = 0; bar.st = nullptr;
    if (hi - lo > 1) bar = xcd_barrier_post(ctl + CW_BAR + args.li * XCD_BAR_WORDS, MISC + 8);
    F.census = (hi - lo > 1 && lo == 0) ? ctl + CW_BAR + args.li * XCD_BAR_WORDS : nullptr;
#ifndef PH_MASK
#define PH_MASK 0x7fffff
#endif
#define IN(k) ((((PH_MASK) >> (k)) & 1) && lo <= (k) && (k) < hi)
#ifndef MK_DUP
#define MK_DUP 0
#endif
#define REP(k) for (int rep_ = 0; rep_ < 1 + (((MK_DUP) >> (k)) & 1); ++rep_)
#define SEAM(k) do { if (IN(k) && IN((k) + 1)) xcd_barrier(bar); } while (0)
    unsigned char* ws = F.ws;
    float* XS0 = (float*)(ws + WS_XS); float* XS1 = XS0 + (size_t)NS * D;
    bf16* HB = (bf16*)(ws + WS_HB); bf16* OB = (bf16*)(ws + WS_OB); float* XR = (float*)(ws + WS_XRES);
    const bf16* WA = (const bf16*)(ws + WS_WA); const bf16* WB = (const bf16*)(ws + WS_WB); const bf16* WC1 = (const bf16*)(ws + WS_WC1); const bf16* WC2 = (const bf16*)(ws + WS_WC2); const bf16* WO = (const bf16*)(ws + WS_WO);
    const float* tab64 = (const float*)(ws + WS_TAB64); const float* tab128 = (const float*)(ws + WS_TAB128);

    if (IN(0)) REP(0) p0_prologue(F);
    SEAM(0);
    if (IN(1)) REP(1) { pg8::StaticOrder S; S.init(M, 8192, F.G, F.bid);
        pg8::EpiAIn E{(bf16*)(ws + WS_QA), (bf16*)(ws + WS_KA), (bf16*)(ws + WS_VA), (bf16*)(ws + WS_GA), F.out + O_AKP, F.out + O_AKS, F.out + O_AVP, F.out + O_AVS, tab64, QSCALE_A};
        run_gemm(F, HB, WA, M, 8192, D, S, E);
        if (rep_ == 0) { const int nfull = (1088 + F.G - 1) / F.G, nlong = 1088 - (nfull - 1) * F.G;
            if (F.bid >= nlong) { __syncthreads(); conv_deferred2(F, F.bid - nlong, F.G - nlong); } else if (nlong >= F.G) { __syncthreads(); conv_deferred2(F, F.bid, F.G); } } }
    SEAM(1);
    if (IN(2)) REP(2) p_attn_a(F, 0, 0.2f, rep_);
    SEAM(2);
    if (IN(3)) REP(3) p_attn_combine<0>(F, 0, 0.2f);
    SEAM(3);
    if (IN(4)) REP(4) { pg8::OutOrder S; S.init(F.G, F.bid); pg8::EpiOut E{F.a->in[0], XR, (float*)(ws + WS_PART)}; run_gemm(F, OB, WO, M, D, D, S, E); }
    SEAM(4);
    if (IN(5)) REP(5) p_norm(F, XR, F.a->in[1], F.a->in[9] + 1 * D, 0, true, XS0);
    SEAM(5);
    if (IN(6)) REP(6) { pg8::StaticOrder S; S.init(M, 6400, F.G, F.bid);
        pg8::EpiBIn E{(bf16*)(ws + WS_QB), (bf16*)(ws + WS_KB), (bf16*)(ws + WS_VB), (bf16*)(ws + WS_QI), (bf16*)(ws + WS_KI), (bf16*)(ws + WS_GB), (float*)(ws + WS_WI),
                      F.out + O_BKP, F.out + O_BKS, F.out + O_BVP, F.out + O_BVS, F.out + O_BIP, F.out + O_BIS, tab64, tab128, QSCALE_B};
        run_gemm(F, HB, WB, M, 6400, D, S, E); }
    SEAM(6);
    if (IN(7)) REP(7) p_idx(F, rep_);
    SEAM(7);
    if (IN(8)) REP(8) p_idx_select(F);
    SEAM(8);
    if (IN(9)) REP(9) p_attn_b(F);
    SEAM(9);
    if (IN(10)) REP(10) p_attn_combine<1>(F, 0, 0.f);
    SEAM(10);
    if (IN(11)) REP(11) { pg8::OutOrder S; S.init(F.G, F.bid); pg8::EpiOut E{XR, XR, (float*)(ws + WS_PART)}; run_gemm(F, OB, WO + (size_t)1 * D * D, M, D, D, S, E); }
    SEAM(11);
    if (IN(12)) REP(12) p_norm_lerp(F, XR, XS0, F.a->in[9] + 2 * D, XS1);
    SEAM(12);
    if (IN(13)) REP(13) { pg8::COrder S{F.G, F.bid}; pg8::EpiC1 E{(float*)(ws + WS_R), (bf16*)(ws + WS_XL), (size_t)M * D}; run_gemm(F, (const bf16*)(ws + WS_L6), WC1, 6 * M, 34 * 256, D, S, E); }
    SEAM(13);
    if (IN(14)) REP(14) { pg8::StaticOrder S; S.init(M, 4096, F.G, F.bid); pg8::EpiC2 E{(float*)(ws + WS_DEC), (float*)(ws + WS_AS), F.a->in[18], F.a->in[21]}; run_gemm(F, (const bf16*)(ws + WS_XL), WC2, M, 4096, 256, S, E); }
    SEAM(14);
    if (IN(15)) REP(15) p_scan(F, rep_);
    SEAM(15);
    if (IN(16)) REP(16) { pg8::OutOrder S; S.init(F.G, F.bid); pg8::EpiOut E{XR, XR, (float*)(ws + WS_PART)}; run_gemm(F, OB, WO + (size_t)2 * D * D, M, D, D, S, E); }
    SEAM(16);
    if (IN(17)) REP(17) p_norm(F, XR, XS1, F.a->in[9] + 3 * D, 0, true, XS0);
    SEAM(17);
    if (IN(18)) REP(18) { pg8::StaticOrder S; S.init(M, 8192, F.G, F.bid);
        pg8::EpiAIn E{(bf16*)(ws + WS_QA), (bf16*)(ws + WS_KA), (bf16*)(ws + WS_VA), (bf16*)(ws + WS_GA), F.out + O_AKP + (size_t)NP * D, F.out + O_AKS + (size_t)NS * D, F.out + O_AVP + (size_t)NP * D, F.out + O_AVS + (size_t)NS * D, tab64, QSCALE_A};
        run_gemm(F, HB, WA + (size_t)8192 * D, M, 8192, D, S, E); }
    SEAM(18);
    if (IN(19)) REP(19) p_attn_a(F, 1, 0.8f - 0.6f * 0.40656965974059911f, rep_);
    SEAM(19);
    if (IN(20)) REP(20) p_attn_combine<0>(F, 1, 0.8f - 0.6f * 0.40656965974059911f);
    SEAM(20);
    if (IN(21)) REP(21) { pg8::OutOrder S; S.init(F.G, F.bid); pg8::EpiOut E{XR, XR, (float*)(ws + WS_PART)}; run_gemm(F, OB, WO + (size_t)3 * D * D, M, D, D, S, E); }
    SEAM(21);
    if (IN(22)) REP(22) p_norm(F, XR, XS0, F.a->in[10], 2, true, XS1);
#undef IN
#undef SEAM
}

#ifndef MK_CUTS
#define MK_CUTS 1
#endif
static int mk_setup() {
    static int grid = 0;
    if (grid == 0) {
        int dev = 0, cus = 0, per_cu = 0;
        if (hipGetDevice(&dev) != hipSuccess || hipDeviceGetAttribute(&cus, hipDeviceAttributeMultiprocessorCount, dev) != hipSuccess) { fprintf(stderr, "kernel_launch: device query failed\n"); grid = -1; return grid; }
        if (hipFuncSetAttribute((const void*)mega, hipFuncAttributeMaxDynamicSharedMemorySize, LDS_BYTES) != hipSuccess) { fprintf(stderr, "kernel_launch: hipFuncSetAttribute failed\n"); grid = -1; return grid; }
        if (hipOccupancyMaxActiveBlocksPerMultiprocessor(&per_cu, (const void*)mega, NTHR, LDS_BYTES) != hipSuccess || per_cu < 1) fprintf(stderr, "kernel_launch: occupancy query reports %d\n", per_cu);
        (void)hipGetLastError();
        grid = cus;
    }
    return grid;
}
static void mk_launch(void* const* d_in, float* d_out, void* d_ws, hipStream_t stream, int ncuts, const int* cuts) {
    const int grid = mk_setup(); if (grid <= 0) return;
    (void)hipMemsetAsync((char*)d_ws + WS_CTL, 0, CTL_ZERO_BYTES, stream);
    Args a{};
    for (int i = 0; i < 29; ++i) a.in[i] = (const float*)d_in[i];
    a.out = d_out; a.ws = (unsigned char*)d_ws;
    for (int li = 0; li < ncuts; ++li) { a.ph_lo = cuts[li]; a.ph_hi = cuts[li + 1]; a.li = li; a.pad = 0;
        hipLaunchKernelGGL(mega, dim3(grid), dim3(NTHR), LDS_BYTES, stream, a);
        const hipError_t le = hipPeekAtLastError(); if (le != hipSuccess) { fprintf(stderr, "kernel_launch: launch %d failed: %s\n", li, hipGetErrorName(le)); break; } }
}
extern "C" void kernel_launch(void* const* d_in, const int* in_sizes, int n_in, void* d_out, int out_size, void* d_ws, size_t ws_size, hipStream_t stream) {
    if (n_in != 29 || (size_t)out_size != O_TOTAL || ws_size < WS_END) { fprintf(stderr, "kernel_launch: unexpected shapes n_in %d out %d ws %zu (need %zu)\n", n_in, out_size, ws_size, (size_t)WS_END); return; }
#if MK_CUTS == 1
    const int cuts[2] = {0, NPHASES}; mk_launch(d_in, (float*)d_out, d_ws, stream, 1, cuts);
#else
    int cuts[NPHASES + 1]; for (int i = 0; i <= NPHASES; ++i) cuts[i] = i; mk_launch(d_in, (float*)d_out, d_ws, stream, NPHASES, cuts);
#endif
}
```

```cpp
#include <hip/hip_runtime.h>
#include <cstdio>
#include <cstdint>
#include <cmath>
#define MK_CUTS 1
namespace pg8 {
#define PG8_LAS __attribute__((address_space(3)))
typedef unsigned short bf16_t;
typedef short bf16x8 __attribute__((ext_vector_type(8)));
typedef float f32x4 __attribute__((ext_vector_type(4)));
typedef unsigned u32x4 __attribute__((ext_vector_type(4)));
constexpr int BM = 256, BK = 64, HALF = 128, HTB = HALF * BK * 2  , STAGE_BYTES = 8 * HTB, NXCD = 8, WGM = 8;

__host__ __device__ __forceinline__ int lds_byte(int r, int c) { const int st = (r >> 4) * 2 + (c >> 5), rr = r & 15, cc = c & 31, ob = rr * 64 + cc * 2; return st * 1024 + (ob ^ (((ob >> 9) & 1) << 5)); }
__host__ __device__ __forceinline__ void stage_rc(int b, int& R, int& C) { const int st = b / 1024, sb = b % 1024, swz = sb ^ (((sb >> 9) & 1) << 5); R = (st >> 1) * 16 + swz / 64; C = (st & 1) * 32 + (swz % 64) / 2; }
__host__ __device__ __forceinline__ int perm32(int rho) { const int n = rho >> 4, i = rho & 15; return 8 * (i >> 2) + 4 * n + (i & 3); }

struct Unit { int pm, pn, k0, nt; };
struct Gemm { const bf16_t* A; const bf16_t* Bt; int M, N, K, ld; };

struct StaticOrder {
    int nM, nN, nwg, G, c;
    __host__ __device__ void init(int M, int N, int G_, int c_) { nM = M / BM; nN = N / BM; nwg = nM * nN; G = G_; c = c_; }
    __host__ __device__ bool next(int i, Unit& u) const {
        const long L = (long)i * G + c; if (L >= nwg) return false;
        int wgid = (int)L; { const int q = nwg / NXCD, r = nwg % NXCD, xcd = wgid % NXCD, off = wgid / NXCD; wgid = (xcd < r ? xcd * (q + 1) : r * (q + 1) + (xcd - r) * q) + off; }
        const int nig = WGM * nN, gid = wgid / nig, fm = gid * WGM, gsz = (nM - fm) < WGM ? (nM - fm) : WGM;
        u.pm = fm + ((wgid % nig) % gsz); u.pn = (wgid % nig) / gsz; return true;
    }
    __device__ __forceinline__ void a_ready(const Unit&) const {}
    __device__ __forceinline__ void done(const Unit&) const {}
};
__device__ __forceinline__ unsigned cvt_pk_bf16(float lo, float hi) { unsigned r; asm volatile("v_cvt_pk_bf16_f32 %0, %1, %2" : "=v"(r) : "v"(lo), "v"(hi)); return r; }
typedef float f32x2 __attribute__((ext_vector_type(2)));
template <class Epi, class Sched, bool ALIGN_EPI = false, bool SP2 = false>
__device__ __forceinline__ void gemm_phase(PG8_LAS unsigned char* lds, const Gemm g, const Sched& S, const Epi& E) {
    const int tid = threadIdx.x, wid = __builtin_amdgcn_readfirstlane(tid >> 6), lane = tid & 63, wr = wid >> 2, wc = wid & 3, fr = lane & 15, fq = lane >> 4;
    const int K = g.ld, nt_full = g.K / BK;
    unsigned voffA[2], voffB[2];
#pragma unroll
    for (int i = 0; i < 2; ++i) { int R, C; stage_rc(tid * 16 + i * 8192, R, C); const int Rb = Epi::PERM ? ((R & ~31) + perm32(R & 31)) : R;
        voffA[i] = (unsigned)(R * K + C) * 2u; voffB[i] = (unsigned)(Rb * K + C) * 2u; }
    const size_t kstep = (size_t)(BK * 2);
    const size_t hstep = (size_t)HALF * K * 2;
    const size_t tstep = 2 * hstep;
    const unsigned ldsw = (unsigned)wid * 1024u;
    const int aoff = lds_byte(wr * 64 + fr, fq * 8), boff = lds_byte(wc * 32 + fr, fq * 8);
#define PG8_SA(b, h) (((b) * 2 + (h)) * HTB)
#define PG8_SB(b, h) ((4 + (b) * 2 + (h)) * HTB)
#define PG8_STAGE(bufoff, gbase, voff) do { _Pragma("unroll") for (int _i = 0; _i < 2; ++_i) \
        __builtin_amdgcn_global_load_lds((const unsigned*)((const char*)(gbase) + (voff)[_i]), (PG8_LAS unsigned*)(lds + (bufoff) + ldsw + _i * 8192), 16, 0, 0); } while (0)
#define PG8_LDA(dst, b, h) do { _Pragma("unroll") for (int m = 0; m < 4; ++m) _Pragma("unroll") for (int k = 0; k < 2; ++k) dst[m][k] = *(const PG8_LAS bf16x8*)(lds + PG8_SA(b, h) + aoff + m * 2048 + k * 1024); } while (0)
#define PG8_LDB(dst, b, h) do { _Pragma("unroll") for (int n = 0; n < 2; ++n) _Pragma("unroll") for (int k = 0; k < 2; ++k) dst[n][k] = *(const PG8_LAS bf16x8*)(lds + PG8_SB(b, h) + boff + n * 2048 + k * 1024); } while (0)
#define PG8_MMA(ai, bj, At, Bt) do { __builtin_amdgcn_s_setprio(1); _Pragma("unroll") for (int m = 0; m < 4; ++m) _Pragma("unroll") for (int n = 0; n < 2; ++n) _Pragma("unroll") for (int k = 0; k < 2; ++k) \
        acc[ai][bj][m][n] = __builtin_amdgcn_mfma_f32_16x16x32_bf16(Bt[n][k], At[m][k], acc[ai][bj][m][n], 0, 0, 0); __builtin_amdgcn_s_setprio(0); } while (0)
#define PG8_WAIT_V(n) asm volatile("s_waitcnt vmcnt(" #n ")" ::: "memory")
#define PG8_WAIT_L(n) asm volatile("s_waitcnt lgkmcnt(" #n ")" ::: "memory")
#define PG8_BAR __builtin_amdgcn_s_barrier()
#define PG8_SCHED __builtin_amdgcn_sched_barrier(0)
    Unit cur, nxt; int ui = 0;
    cur.k0 = 0; cur.nt = nt_full; if (!S.next(0, cur)) return;
    f32x4 acc[2][2][4][2];
#pragma unroll
    for (int a = 0; a < 2; ++a)
#pragma unroll
        for (int b = 0; b < 2; ++b)
#pragma unroll
            for (int m = 0; m < 4; ++m)
#pragma unroll
                for (int n = 0; n < 2; ++n) acc[a][b][m][n] = (f32x4){0.f, 0.f, 0.f, 0.f};
    bf16x8 At[4][2], B0[2][2], B1[2][2];
    const char* cA = (const char*)g.A + (size_t)cur.pm * tstep + (size_t)cur.k0 * 2; const char* cB = (const char*)g.Bt + (size_t)cur.pn * tstep + (size_t)cur.k0 * 2;
    S.a_ready(cur);
    if constexpr (SP2) {
        PG8_STAGE(PG8_SB(0, 0), cB, voffB); PG8_STAGE(PG8_SB(0, 1), cB + hstep, voffB); PG8_STAGE(PG8_SA(0, 0), cA, voffA); PG8_STAGE(PG8_SA(0, 1), cA + hstep, voffA);
        if (wr == 1) PG8_BAR;
        PG8_WAIT_V(2); PG8_BAR;
        PG8_STAGE(PG8_SB(1, 0), cB + kstep, voffB); PG8_STAGE(PG8_SA(1, 0), cA + kstep, voffA); PG8_STAGE(PG8_SB(1, 1), cB + hstep + kstep, voffB);
        PG8_WAIT_V(6); PG8_BAR;
    } else {
        PG8_STAGE(PG8_SB(0, 0), cB, voffB); PG8_STAGE(PG8_SA(0, 0), cA, voffA); PG8_STAGE(PG8_SB(0, 1), cB + hstep, voffB); PG8_STAGE(PG8_SA(0, 1), cA + hstep, voffA);
        if (wr == 1) PG8_BAR;
        PG8_WAIT_V(4); PG8_BAR;
        PG8_STAGE(PG8_SB(1, 0), cB + kstep, voffB); PG8_STAGE(PG8_SA(1, 0), cA + kstep, voffA); PG8_STAGE(PG8_SB(1, 1), cB + hstep + kstep, voffB);
        PG8_WAIT_V(6); PG8_BAR;
    }
    for (;;) {
        nxt.k0 = 0; nxt.nt = nt_full; const bool has_next = S.next(ui + 1, nxt); const int nt = cur.nt;
        const char* nA = has_next ? (const char*)g.A + (size_t)nxt.pm * tstep + (size_t)nxt.k0 * 2 : cA; const char* nB = has_next ? (const char*)g.Bt + (size_t)nxt.pn * tstep + (size_t)nxt.k0 * 2 : cB;
        for (int t = 0; t < nt; t += 2) {
            const bool last = (t == nt - 2);
            const char* a1 = cA + (size_t)(t + 1) * kstep;
            const char* a2 = last ? nA : cA + (size_t)(t + 2) * kstep; const char* b2 = last ? nB : cB + (size_t)(t + 2) * kstep;
            const char* a3 = a2 + kstep; const char* b3 = b2 + kstep;
            if (last && has_next) S.a_ready(nxt);
            if constexpr (SP2) {
            PG8_LDB(B0, 0, 0); PG8_LDB(B1, 0, 1); PG8_SCHED; PG8_LDA(At, 0, 0); PG8_STAGE(PG8_SA(1, 1), a1 + hstep, voffA);
            PG8_WAIT_V(8); PG8_WAIT_L(0); PG8_BAR; PG8_MMA(0, 0, At, B0); PG8_MMA(0, 1, At, B1); PG8_BAR; PG8_SCHED;
            PG8_LDA(At, 0, 1); PG8_STAGE(PG8_SB(0, 0), b2, voffB); PG8_STAGE(PG8_SB(0, 1), b2 + hstep, voffB); PG8_STAGE(PG8_SA(0, 0), a2, voffA);
            PG8_WAIT_V(8); PG8_WAIT_L(0); PG8_BAR; PG8_MMA(1, 0, At, B0); PG8_MMA(1, 1, At, B1); PG8_BAR; PG8_SCHED;
            PG8_LDB(B0, 1, 0); PG8_LDB(B1, 1, 1); PG8_SCHED; PG8_LDA(At, 1, 0); PG8_STAGE(PG8_SA(0, 1), a2 + hstep, voffA);
            PG8_WAIT_V(8); PG8_WAIT_L(0); PG8_BAR; PG8_MMA(0, 0, At, B0); PG8_MMA(0, 1, At, B1); PG8_BAR; PG8_SCHED;
            PG8_LDA(At, 1, 1); PG8_STAGE(PG8_SB(1, 0), b3, voffB); PG8_STAGE(PG8_SB(1, 1), b3 + hstep, voffB); PG8_STAGE(PG8_SA(1, 0), a3, voffA);
            PG8_WAIT_V(8); PG8_WAIT_L(0); PG8_BAR; PG8_MMA(1, 0, At, B0); PG8_MMA(1, 1, At, B1); PG8_BAR; PG8_SCHED;
            } else {
            PG8_LDB(B0, 0, 0); PG8_SCHED; PG8_LDA(At, 0, 0); PG8_STAGE(PG8_SA(1, 1), a1 + hstep, voffA);
            PG8_WAIT_L(8); PG8_BAR; PG8_WAIT_L(0); PG8_MMA(0, 0, At, B0); PG8_BAR; PG8_SCHED;
            PG8_LDB(B1, 0, 1); PG8_STAGE(PG8_SB(0, 0), b2, voffB);
            PG8_BAR; PG8_WAIT_L(0); PG8_MMA(0, 1, At, B1); PG8_BAR;
            PG8_LDA(At, 0, 1); PG8_STAGE(PG8_SA(0, 0), a2, voffA);
            PG8_BAR; PG8_WAIT_L(0); PG8_MMA(1, 0, At, B0); PG8_BAR; PG8_SCHED;
            PG8_STAGE(PG8_SB(0, 1), b2 + hstep, voffB);
            PG8_WAIT_V(6); PG8_BAR; PG8_MMA(1, 1, At, B1); PG8_BAR;
            PG8_LDB(B0, 1, 0); PG8_SCHED; PG8_LDA(At, 1, 0); PG8_STAGE(PG8_SA(0, 1), a2 + hstep, voffA);
            PG8_WAIT_L(8); PG8_BAR; PG8_WAIT_L(0); PG8_MMA(0, 0, At, B0); PG8_BAR; PG8_SCHED;
            PG8_LDB(B1, 1, 1); PG8_STAGE(PG8_SB(1, 0), b3, voffB);
            PG8_BAR; PG8_WAIT_L(0); PG8_MMA(0, 1, At, B1); PG8_BAR;
            PG8_LDA(At, 1, 1); PG8_STAGE(PG8_SA(1, 0), a3, voffA);
            PG8_BAR; PG8_WAIT_L(0); PG8_MMA(1, 0, At, B0); PG8_BAR; PG8_SCHED;
            PG8_STAGE(PG8_SB(1, 1), b3 + hstep, voffB);
            PG8_WAIT_V(6); PG8_BAR; PG8_MMA(1, 1, At, B1); PG8_BAR;
            }
        }
        if constexpr (ALIGN_EPI) { if (wr == 0) PG8_BAR; }
        if constexpr (!Epi::AFTER_DRAIN) { E(acc, cur, wr, wc, fr, fq); S.done(cur); }
        if (!has_next) break;
#pragma unroll
        for (int a = 0; a < 2; ++a)
#pragma unroll
            for (int b = 0; b < 2; ++b)
#pragma unroll
                for (int m = 0; m < 4; ++m)
#pragma unroll
                    for (int n = 0; n < 2; ++n) acc[a][b][m][n] = (f32x4){0.f, 0.f, 0.f, 0.f};
        cur = nxt; cA = nA; cB = nB; ++ui;
        if constexpr (ALIGN_EPI) { if (wr == 1) PG8_BAR; }
    }
    PG8_WAIT_V(0);
    if constexpr (!ALIGN_EPI) { if (wr == 0) PG8_BAR; }
    PG8_BAR;
    if constexpr (Epi::AFTER_DRAIN) { E.fused(acc, cur, wr, wc, fr, fq, lds, wid, lane); S.done(cur); }
#undef PG8_SA
#undef PG8_SB
#undef PG8_STAGE
#undef PG8_LDA
#undef PG8_LDB
#undef PG8_MMA
#undef PG8_WAIT_V
#undef PG8_WAIT_L
#undef PG8_BAR
#undef PG8_SCHED
}
}
#define GAS __attribute__((address_space(1)))
#define LAS __attribute__((address_space(3)))
typedef unsigned short bf16;
typedef unsigned v4u __attribute__((ext_vector_type(4)));
typedef unsigned v2u __attribute__((ext_vector_type(2)));
typedef float f32x4 __attribute__((ext_vector_type(4)));
typedef float f32x2 __attribute__((ext_vector_type(2)));
typedef float f32x16 __attribute__((ext_vector_type(16)));
typedef short bf16x8 __attribute__((ext_vector_type(8)));
typedef short s16x4 __attribute__((ext_vector_type(4)));
typedef GAS unsigned gu32;

constexpr int D = 2048, NP = 8192, NS = 512, M = NP + NS, TP = 2048, TS = 64, PAST = 4096, SALL = PAST + TS, NPOS = TP + TS;
constexpr int NWAVES = 8, NTHR = 512;
constexpr float LOG2E = 1.4426950408889634f;
constexpr float QSCALE_A = 0.125f * LOG2E, QSCALE_B = 0.08838834764831845f * LOG2E;
constexpr int NA_TILES = 32, NB_TILES = 25, NC1_TILES = 34, NC2_TILES = 16;
constexpr int MASKW = 132;

constexpr size_t O_YP = 0, O_YS = O_YP + (size_t)NP * D, O_AKP = O_YS + (size_t)NS * D, O_AVP = O_AKP + 2ull * NP * D, O_AKS = O_AVP + 2ull * NP * D, O_AVS = O_AKS + 2ull * NS * D,
                 O_BKP = O_AVS + 2ull * NS * D, O_BVP = O_BKP + (size_t)NP * 512, O_BIP = O_BVP + (size_t)NP * 512, O_BKS = O_BIP + (size_t)NP * 64, O_BVS = O_BKS + (size_t)NS * 512, O_BIS = O_BVS + (size_t)NS * 512,
                 O_CWP = O_BIS + (size_t)NS * 64, O_CHP = O_CWP + 4ull * 32 * 4096, O_CWS = O_CHP + 4ull * D, O_CHS = O_CWS + 8ull * 32 * 4096, O_TOTAL = O_CHS + 8ull * D;

constexpr size_t MiB = 1u << 20;
#if MK_CUTS == 1
constexpr size_t WS_CTL = 0, CTL_ZERO_BYTES = 40 * 1024;
#else
constexpr size_t WS_CTL = 0, CTL_ZERO_BYTES = 1 * MiB;
#endif
constexpr size_t WS_TAB64 = 3 * MiB;
constexpr size_t WS_TAB128 = WS_TAB64 + (size_t)NPOS * 32 * 8;
constexpr size_t WS_WA = 5 * MiB;
constexpr size_t WS_WB = WS_WA + 2ull * 8192 * 2048 * 2;
constexpr size_t WS_WC1 = WS_WB + 6400ull * 2048 * 2;
constexpr size_t WS_WC2 = WS_WC1 + 8704ull * 2048 * 2;
constexpr size_t WS_WO = WS_WC2 + 4096ull * 256 * 2;
constexpr size_t WS_XRES = WS_WO + 4ull * 2048 * 2048 * 2;
constexpr size_t MD2 = (size_t)M * D * 2, MD4 = (size_t)M * D * 4;
constexpr size_t WS_OB = WS_XRES + MD4;
constexpr size_t WS_PART = WS_OB + MD2;
constexpr size_t WS_XS = WS_PART + 8ull * NS * D * 4;
constexpr size_t WS_APART = WS_XS + 2ull * NS * D * 4;
constexpr size_t WS_U = WS_APART + 8ull * NS * 32 * 130 * 4;
constexpr size_t WS_HB = WS_U;
constexpr size_t WS_QA = WS_HB + MD2, WS_KA = WS_QA + MD2, WS_VA = WS_KA + MD2, WS_GA = WS_VA + MD2;
constexpr size_t WS_QB = WS_HB + MD2, WS_GB = WS_QB + MD2, WS_KB = WS_GB + MD2, WS_VB = WS_KB + (size_t)M * 512 * 2, WS_QI = WS_VB + (size_t)M * 512 * 2,
                 WS_KI = WS_QI + (size_t)M * 1024 * 2, WS_WI = WS_KI + (size_t)M * 64 * 2, WS_MASK = WS_WI + (size_t)M * 16 * 4, WS_SC = WS_MASK + (size_t)M * MASKW * 4;
constexpr size_t SC_S_OFF = (size_t)NP * 2048;
constexpr size_t WS_B_END = WS_SC + ((size_t)NP * 2048 + (size_t)NS * 4160) * 4;
constexpr size_t WS_L6 = WS_U;
constexpr size_t WS_R = WS_L6 + 6 * MD2, WS_K = WS_R + MD4, WS_V = WS_K + MD4, WS_G = WS_V + MD4, WS_DEC = WS_G + MD4, WS_AS = WS_DEC + MD4, WS_XL = WS_AS + MD4;
constexpr size_t WS_C_END = WS_XL + (size_t)M * 256 * 2;
constexpr size_t WS_END0 = (WS_C_END > WS_B_END ? WS_C_END : WS_B_END);
constexpr size_t WS_KC = (WS_END0 + 4095) & ~(size_t)4095;
constexpr size_t WS_VC = WS_KC + 8ull * PAST * D * 2;
constexpr size_t WS_END = WS_VC + 8ull * PAST * D * 2;
#if MK_CUTS == 1
constexpr int CW_TMO = 0, CW_BAR = 4096, N_BAR_REGIONS = 1;
#else
constexpr int CW_TMO = 0, CW_BAR = 4096, N_BAR_REGIONS = 24;
#endif
static_assert((CW_BAR + N_BAR_REGIONS * 3456) * 4 <= (int)CTL_ZERO_BYTES, "ctl");
constexpr int RING_BYTES = 131072, LDS_BYTES = 147456, MISC_OFF = LDS_BYTES - 512;

__device__ __forceinline__ unsigned f2bf(float f) { unsigned u = __builtin_bit_cast(unsigned, f); return (u + 0x7fffu + ((u >> 16) & 1u)) >> 16; }
__device__ __forceinline__ unsigned pk2(float lo, float hi) { return f2bf(lo) | (f2bf(hi) << 16); }
__device__ __forceinline__ unsigned cvtpk(float lo, float hi) { typedef __bf16 b2 __attribute__((ext_vector_type(2))); f32x2 v = {lo, hi}; b2 b = __builtin_convertvector(v, b2); return __builtin_bit_cast(unsigned, b); }
__device__ __forceinline__ float bf_lo(unsigned u) { return __builtin_bit_cast(float, u << 16); }
__device__ __forceinline__ float bf_hi(unsigned u) { return __builtin_bit_cast(float, u & 0xffff0000u); }
__device__ __forceinline__ float silu_f(float x) { return x * __builtin_amdgcn_rcpf(1.f + __expf(-x)); }
__device__ __forceinline__ float wave_sum(float v) {
#pragma unroll
    for (int o = 1; o < 64; o <<= 1) v += __shfl_xor(v, o);
    return v;
}
__device__ __forceinline__ int pos_index(int row) { return row < NP ? (row & (TP - 1)) : TP + ((row - NP) & (TS - 1)); }
__device__ __forceinline__ int lane_now() { return (int)__builtin_amdgcn_mbcnt_hi(~0u, __builtin_amdgcn_mbcnt_lo(~0u, 0u)); }
#define LDS_WAIT() asm volatile("s_waitcnt lgkmcnt(0)" ::: "memory")
#define VM_WAIT() asm volatile("s_waitcnt vmcnt(0)" ::: "memory")

struct Args { const float* in[29]; float* out; unsigned char* ws; int ph_lo, ph_hi, li, pad; };
struct Frame {
    LAS unsigned char* lds;
    int tid, lane, wave, G, bid;
    const __attribute__((address_space(4))) Args* a; float* out; unsigned char* ws; unsigned* census;
};

__device__ __forceinline__ int orig64(int s) { const int wc = s >> 5, n = (s >> 4) & 1, r = s & 15; return 64 * (wc >> 1) + 32 * n + 16 * (wc & 1) + r; }
__device__ __forceinline__ int orig128(int s) { const int wc = s >> 5, n = (s >> 4) & 1, r = s & 15; return 64 * n + 16 * wc + r; }
enum MapId { MAP_ID = 0, MAP_A = 1, MAP_B = 2, MAP_PAD96 = 3 };
__device__ __forceinline__ int wide256(int s) { const int bj = s >> 7, wc = (s >> 5) & 3, nn = (s >> 4) & 1, fq = (s >> 2) & 3, e = s & 3; return 64 * wc + 32 * bj + 8 * fq + 4 * nn + e; }
__device__ __forceinline__ int colmap(int map, int n) {
    if (map == MAP_ID) return n;
    if (map == MAP_PAD96) return n < 96 ? n : -1;
    const int T = n >> 8, base = n & ~127, s = n & 127, bj = (n >> 7) & 1, wide = (n & ~255) + wide256(n & 255);
    if (map == MAP_A) return wide;
    if (T < 10) return base + orig128(s);
    if (T < 16) return wide;
    if (T == 16) { if (bj) return -1; const int o = orig64(s); return o < 64 ? 4096 + o : (o < 80 ? 4160 + (o - 64) : -1); }
    return 4176 + (wide - 17 * 256);
}
__device__ __forceinline__ void conv_item(const float* W, int ldw, bf16* WT, int ldd, int map, int item, int nblk, LAS float* scr, int lane) {
    const int kb = item / nblk, nb = item % nblk, k0 = 64 * kb, n0 = 32 * nb;
    const int n4 = lane & 7, kr = lane >> 3;
    const int src = colmap(map, n0 + 4 * n4);
    f32x4 v[8];
#pragma unroll
    for (int i = 0; i < 8; ++i) v[i] = src >= 0 ? *(const GAS f32x4*)(W + (size_t)(k0 + kr + 8 * i) * ldw + src) : (f32x4){0.f, 0.f, 0.f, 0.f};
#pragma unroll
    for (int i = 0; i < 8; ++i) { LAS float* p = scr + (kr + 8 * i) * 33 + 4 * n4; p[0] = v[i][0]; p[1] = v[i][1]; p[2] = v[i][2]; p[3] = v[i][3]; }
    LDS_WAIT(); asm volatile("" ::: "memory");
    const int c = lane & 7;
#pragma unroll
    for (int j = 0; j < 4; ++j) { const int n = (lane >> 3) + 8 * j; const LAS float* s = scr + (8 * c) * 33 + n;
        v4u o; o.x = cvtpk(s[0 * 33], s[1 * 33]); o.y = cvtpk(s[2 * 33], s[3 * 33]); o.z = cvtpk(s[4 * 33], s[5 * 33]); o.w = cvtpk(s[6 * 33], s[7 * 33]);
        *(GAS v4u*)(WT + (size_t)(n0 + n) * ldd + k0 + 8 * c) = o; }
    LDS_WAIT(); asm volatile("" ::: "memory");
}
template <bool WIDE> __device__ __forceinline__ int rix(int lane, int j) { return WIDE ? 2 * lane + (j & 1) + 128 * (j >> 1) : lane + 64 * j; }
template <bool WIDE = false>
__device__ __forceinline__ void rms_row(const float* xrow, const float* g, int lane, f32x4 (&v)[8], const float* part = nullptr, float* wb = nullptr) {
    const GAS f32x4* xr = (const GAS f32x4*)xrow; float s = 0.f;
#pragma unroll
    for (int j = 0; j < 8; ++j) v[j] = xr[rix<WIDE>(lane, j)];
    if (part) {
#pragma unroll
        for (int sl = 0; sl < 8; ++sl) { const GAS f32x4* pr = (const GAS f32x4*)(part + (size_t)sl * NS * D);
#pragma unroll
            for (int j = 0; j < 8; ++j) v[j] = v[j] + pr[rix<WIDE>(lane, j)]; }
        if (wb) { GAS f32x4* o = (GAS f32x4*)wb;
#pragma unroll
            for (int j = 0; j < 8; ++j) o[rix<WIDE>(lane, j)] = v[j]; } }
#pragma unroll
    for (int j = 0; j < 8; ++j) s += (v[j].x * v[j].x + v[j].y * v[j].y) + (v[j].z * v[j].z + v[j].w * v[j].w);
    const float r = rsqrtf(wave_sum(s) * (1.f / D) + 1e-6f);
    const GAS f32x4* gr = (const GAS f32x4*)g;
#pragma unroll
    for (int j = 0; j < 8; ++j) v[j] = v[j] * r * gr[rix<WIDE>(lane, j)];
}
__device__ __forceinline__ const float* xrow_ptr(const float* xp, const float* xs, int row) { return row < NP ? xp + (size_t)row * D : xs + (size_t)(row - NP) * D; }
__device__ __forceinline__ int norm_row(int gw, int NGW, int k) {
    if (NGW != 2048) { const int r = gw + k * NGW; return r < M ? r : -1; }
    if (gw < 512) return k == 0 ? NP + gw : (k == 1 ? 7680 + gw : -1);
    const int r = (gw - 512) + k * 1536; return r < 7680 ? r : -1;
}
__device__ __forceinline__ void p_norm(Frame& F, const float* xp, const float* xs, const float* g, int mode, bool merge, float* xs_out) {
    const int gw = F.bid * NWAVES + F.wave, NGW = F.G * NWAVES;
    bf16* HB = (bf16*)(F.ws + WS_HB);
    for (int k = 0;; ++k) { const int row = norm_row(gw, NGW, k); if (row < 0) break;
        f32x4 v[8]; const float* part = row >= NP ? (const float*)(F.ws + WS_PART) + (size_t)(row - NP) * D : nullptr;
        rms_row(xrow_ptr(xp, xs, row), g, lane_now(), v, merge ? part : nullptr, xs_out + (size_t)(row - NP) * D);
        if (mode == 0) { GAS v2u* o = (GAS v2u*)(HB + (size_t)row * D) + lane_now();
#pragma unroll
            for (int j = 0; j < 8; ++j) { v2u w; w.x = cvtpk(v[j].x, v[j].y); w.y = cvtpk(v[j].z, v[j].w); o[64 * j] = w; } }
        else { float* y = row < NP ? F.out + O_YP + (size_t)row * D : F.out + O_YS + (size_t)(row - NP) * D; GAS f32x4* o = (GAS f32x4*)y + lane_now();
#pragma unroll
            for (int j = 0; j < 8; ++j) o[64 * j] = v[j]; }
    }
}
__device__ __forceinline__ void p_norm_lerp(Frame& F, const float* xp, const float* xs, const float* g, float* xs_out) {
    const int gw = F.bid * NWAVES + F.wave, NGW = F.G * NWAVES;
    bf16* L6 = (bf16*)(F.ws + WS_L6); const float* mu = F.a->in[16]; const float* shift0 = F.a->in[8];
    const int lane = F.lane;
    auto emit = [&](int row, const f32x4 (&h)[8], const f32x4 (&pvv)[8]) {
#pragma unroll
        for (int n = 0; n < 6; ++n) { const GAS f32x4* mr = (const GAS f32x4*)(mu + (size_t)n * D); GAS v4u* o = (GAS v4u*)(L6 + ((size_t)n * M + row) * D) + lane;
#pragma unroll
            for (int jj = 0; jj < 4; ++jj) { const f32x4 m0 = mr[rix<true>(lane, 2 * jj)], m1 = mr[rix<true>(lane, 2 * jj + 1)];
                const f32x4 l0 = h[2 * jj] + (pvv[2 * jj] - h[2 * jj]) * m0, l1 = h[2 * jj + 1] + (pvv[2 * jj + 1] - h[2 * jj + 1]) * m1;
                v4u w; w.x = cvtpk(l0.x, l0.y); w.y = cvtpk(l0.z, l0.w); w.z = cvtpk(l1.x, l1.y); w.w = cvtpk(l1.z, l1.w); o[64 * jj] = w; } } };
    auto pair = [&](int r0) {
        const int t0 = r0 & (TP - 1), b = r0 / TP; f32x4 a[8], h0[8], h1[8];
        const GAS f32x4* x0 = (const GAS f32x4*)(xp + (size_t)r0 * D); const GAS f32x4* xa = t0 > 0 ? x0 - D / 4 : x0; const GAS f32x4* x1 = x0 + D / 4;
#pragma unroll
        for (int j = 0; j < 8; ++j) { const int ix = rix<true>(lane, j); a[j] = xa[ix]; h0[j] = x0[ix]; h1[j] = x1[ix]; }
        float sa = 0.f, s0 = 0.f, s1 = 0.f;
#pragma unroll
        for (int j = 0; j < 8; ++j) { sa += (a[j].x * a[j].x + a[j].y * a[j].y) + (a[j].z * a[j].z + a[j].w * a[j].w); s0 += (h0[j].x * h0[j].x + h0[j].y * h0[j].y) + (h0[j].z * h0[j].z + h0[j].w * h0[j].w);
            s1 += (h1[j].x * h1[j].x + h1[j].y * h1[j].y) + (h1[j].z * h1[j].z + h1[j].w * h1[j].w); }
        const float ra = t0 > 0 ? rsqrtf(wave_sum(sa) * (1.f / D) + 1e-6f) : 0.f, q0 = rsqrtf(wave_sum(s0) * (1.f / D) + 1e-6f), q1 = rsqrtf(wave_sum(s1) * (1.f / D) + 1e-6f);
        const GAS f32x4* gr = (const GAS f32x4*)g;
#pragma unroll
        for (int j = 0; j < 8; ++j) { const f32x4 gg = gr[rix<true>(lane, j)]; a[j] = a[j] * ra * gg; h0[j] = h0[j] * q0 * gg; h1[j] = h1[j] * q1 * gg; }
        if (t0 + 1 == TP - 1) { GAS f32x4* o = (GAS f32x4*)(F.out + O_CHP + (size_t)b * D);
#pragma unroll
            for (int j = 0; j < 8; ++j) o[rix<true>(lane, j)] = h1[j]; }
        emit(r0, h0, a); emit(r0 + 1, h1, h0); };
    auto single = [&](int row) {
        const bool samp = row >= NP; const int t = samp ? (row - NP) & (TS - 1) : row & (TP - 1); const int b = samp ? (row - NP) / TS : row / TP;
        const float* part = samp ? (const float*)(F.ws + WS_PART) + (size_t)(row - NP) * D : nullptr;
        f32x4 h[8], pv[8]; rms_row<true>(xrow_ptr(xp, xs, row), g, lane, h, part, xs_out + (size_t)(row - NP) * D);
        if (t > 0) rms_row<true>(xrow_ptr(xp, xs, row - 1), g, lane, pv, samp ? part - D : nullptr, nullptr);
        else {
#pragma unroll
            for (int j = 0; j < 8; ++j) pv[j] = samp ? ((const GAS f32x4*)(shift0 + (size_t)b * D))[rix<true>(lane, j)] : (f32x4){0.f, 0.f, 0.f, 0.f}; }
        const bool last = samp ? (t == TS - 1) : (t == TP - 1);
        if (last) { float* so = samp ? F.out + O_CHS + (size_t)b * D : F.out + O_CHP + (size_t)b * D; GAS f32x4* o = (GAS f32x4*)so;
#pragma unroll
            for (int j = 0; j < 8; ++j) o[rix<true>(lane, j)] = h[j]; }
#pragma unroll
        for (int j = 0; j < 8; ++j) pv[j] = pv[j] - h[j];
#pragma unroll
        for (int n = 0; n < 6; ++n) { const GAS f32x4* mr = (const GAS f32x4*)(mu + (size_t)n * D); GAS v4u* o = (GAS v4u*)(L6 + ((size_t)n * M + row) * D) + lane;
#pragma unroll
            for (int jj = 0; jj < 4; ++jj) { const f32x4 l0 = h[2 * jj] + pv[2 * jj] * mr[rix<true>(lane, 2 * jj)], l1 = h[2 * jj + 1] + pv[2 * jj + 1] * mr[rix<true>(lane, 2 * jj + 1)];
                v4u w; w.x = cvtpk(l0.x, l0.y); w.y = cvtpk(l0.z, l0.w); w.z = cvtpk(l1.x, l1.y); w.w = cvtpk(l1.z, l1.w); o[64 * jj] = w; } }
    };
    if (NGW == 2048) {
        if (gw < 512) { single(NP + gw); single(7680 + gw); }
        else { for (int k = 0; k < 3; ++k) { const int pr = (gw - 512) + 1536 * k; if (pr < 3840) pair(2 * pr); } }
    } else { for (int k = 0;; ++k) { const int row = norm_row(gw, NGW, k); if (row < 0) break; single(row); } }
}
constexpr int CONV_ITEMS = 8192 * 2 + 6400 + 2048 * 4 + 256 * 2 + 2048 * 4;
__device__ __forceinline__ bool conv_is_deferred(int it) { return (it >= 8192 && it < 16384 + 6400 + 8192 + 512) || it >= CONV_ITEMS - 4096; }
__device__ __forceinline__ void conv_dispatch(Frame& F, int it, LAS float* scr) {
    bf16* WA = (bf16*)(F.ws + WS_WA); bf16* WB = (bf16*)(F.ws + WS_WB); bf16* WC1 = (bf16*)(F.ws + WS_WC1); bf16* WO = (bf16*)(F.ws + WS_WO);
    int r = it; const float* W; int ldw, map, rows; bf16* dst;
    if (r < 16384) { const int j = r >> 13; r &= 8191; W = F.a->in[12] + (size_t)j * D * 8192; ldw = 8192; map = MAP_A; dst = WA + (size_t)j * 8192 * D; rows = 8192; }
    else if ((r -= 16384) < 6400) { W = F.a->in[15]; ldw = 6224; map = MAP_B; dst = WB; rows = 6400; }
    else if ((r -= 6400) < 8192) { const int j = r >> 11; r &= 2047; W = F.a->in[17] + (size_t)j * D * D; ldw = D; map = MAP_ID; dst = WC1 + (size_t)j * D * D; rows = 2048; }
    else if ((r -= 8192) < 256) { W = F.a->in[19]; ldw = 96; map = MAP_PAD96; dst = WC1 + (size_t)8192 * D; rows = 256; }
    else if ((r -= 256) < 256) { W = F.a->in[22]; ldw = 96; map = MAP_PAD96; dst = WC1 + (size_t)8448 * D; rows = 256; }
    else { r -= 256; const int j = r >> 11; r &= 2047; W = F.a->in[11] + (size_t)j * D * D; ldw = D; map = MAP_ID; dst = WO + (size_t)j * D * D; rows = 2048; }
    conv_item(W, ldw, dst, D, map, r, rows / 32, scr, F.lane);
}
__device__ __forceinline__ void conv_deferred2(Frame& F, int wg_rank, int nwg) {
    LAS float* scr = (LAS float*)(F.lds + F.wave * 16384);
    for (int k = wg_rank * NWAVES + F.wave; k < 6400 + 8192 + 512; k += nwg * NWAVES) conv_dispatch(F, 16384 + k, scr);
}
__device__ __forceinline__ void conv_deferred(Frame& F, int wg_rank, int nwg) {
    LAS float* scr = (LAS float*)(F.lds + F.wave * 16384);
    for (int k = wg_rank * NWAVES + F.wave; k < 8192 + 4096; k += nwg * NWAVES) { const int it = k < 8192 ? 8192 + k : CONV_ITEMS - 4096 + (k - 8192); conv_dispatch(F, it, scr); }
}
__device__ __forceinline__ void p0_prologue(Frame& F) {
    LAS float* scr = (LAS float*)(F.lds + F.wave * 16384);
    const int gw = F.bid * NWAVES + F.wave, NGW = F.G * NWAVES;
    bf16* WA = (bf16*)(F.ws + WS_WA); bf16* WB = (bf16*)(F.ws + WS_WB); bf16* WC1 = (bf16*)(F.ws + WS_WC1); bf16* WC2 = (bf16*)(F.ws + WS_WC2); bf16* WO = (bf16*)(F.ws + WS_WO);
    for (int it = gw; it < CONV_ITEMS; it += NGW) { if (!conv_is_deferred(it)) conv_dispatch(F, it, scr); }
    { const float* wlb = F.a->in[20]; const float* alb = F.a->in[23];
      for (int idx = (F.bid * NTHR + F.tid); idx < 4096 * 256; idx += F.G * NTHR) { const int k = idx >> 12, n = idx & 4095; float v = 0.f;
          if (n < 2048) { if (k < 96) v = wlb[(size_t)k * D + n]; } else { if (k >= 128 && k < 224) v = alb[(size_t)(k - 128) * D + (n - 2048)]; }
          WC2[(size_t)n * 256 + k] = (bf16)f2bf(v); } }
    { f32x2* t64 = (f32x2*)(F.ws + WS_TAB64); f32x2* t128 = (f32x2*)(F.ws + WS_TAB128);
      for (int idx = (F.bid * NTHR + F.tid); idx < NPOS * 96; idx += F.G * NTHR) { const int p = idx / 96, j = idx % 96; const float pos = (float)(p < TP ? p : PAST + (p - TP));
          if (j < 32) { const float inv = powf(10000.0f, -(float)j * (2.0f / 64.f)); const float a = pos * inv; t64[p * 32 + j] = (f32x2){cosf(a), sinf(a)}; }
          else { const int jj = j - 32; const float inv = powf(10000.0f, -(float)jj * (2.0f / 128.f)); const float a = pos * inv; t128[p * 64 + jj] = (f32x2){cosf(a), sinf(a)}; } } }
    p_norm(F, F.a->in[0], F.a->in[1], F.a->in[9], 0, false, nullptr);
}
#ifndef MK_EXPG
#define MK_EXPG 0
#endif
#ifndef MK_NTA
#define MK_NTA 1
#endif
namespace pg8 {
__device__ __forceinline__ void st_a(const f32x4 v, float* p) { if (MK_NTA) __builtin_nontemporal_store(v, (f32x4*)p); else *(f32x4*)p = v; }
template <int BANK> __device__ __forceinline__ float ror8_merge(float old, float src) { return __builtin_bit_cast(float, __builtin_amdgcn_update_dpp(__builtin_bit_cast(int, old), __builtin_bit_cast(int, src), 0x128, 0xf, BANK, false)); }
__device__ __forceinline__ void rowpair(const f32x4 A, const f32x4 B, bool lo, f32x4& s1, f32x4& s2) {
#pragma unroll
    for (int e = 0; e < 4; ++e) { const float send = lo ? B[e] : A[e]; s1[e] = ror8_merge<0xC>(A[e], send); s2[e] = ror8_merge<0x3>(B[e], send); }
}
__device__ __forceinline__ void rope4(const f32x4 x1, const f32x4 x2, const f32x4 csa, const f32x4 csb, f32x4& o1, f32x4& o2) {
    o1[0] = x1[0] * csa[0] - x2[0] * csa[1]; o2[0] = x2[0] * csa[0] + x1[0] * csa[1];
    o1[1] = x1[1] * csa[2] - x2[1] * csa[3]; o2[1] = x2[1] * csa[2] + x1[1] * csa[3];
    o1[2] = x1[2] * csb[0] - x2[2] * csb[1]; o2[2] = x2[2] * csb[0] + x1[2] * csb[1];
    o1[3] = x1[3] * csb[2] - x2[3] * csb[3]; o2[3] = x2[3] * csb[2] + x1[3] * csb[3];
}
typedef unsigned u32x2 __attribute__((ext_vector_type(2)));
__device__ __forceinline__ u32x2 pack4(const f32x4 v) { u32x2 w; w.x = cvt_pk_bf16(v[0], v[1]); w.y = cvt_pk_bf16(v[2], v[3]); return w; }
__device__ __forceinline__ int pos_index_(int row) { return row < 8192 ? (row & 2047) : 2048 + ((row - 8192) & 63); }
__device__ __forceinline__ float silu_(float x) { return x * __builtin_amdgcn_rcpf(1.f + __expf(-x)); }
__device__ __forceinline__ f32x4 silu4(const f32x4 v) { return (f32x4){silu_(v[0]), silu_(v[1]), silu_(v[2]), silu_(v[3])}; }

__device__ __forceinline__ u32x4 pack8(const f32x4 a, const f32x4 b) { u32x4 w; w.x = cvt_pk_bf16(a[0], a[1]); w.y = cvt_pk_bf16(a[2], a[3]); w.z = cvt_pk_bf16(b[0], b[1]); w.w = cvt_pk_bf16(b[2], b[3]); return w; }
__device__ __forceinline__ void keep4(const f32x4 v) { asm volatile("" :: "v"(v[0]), "v"(v[1]), "v"(v[2]), "v"(v[3])); }
__device__ __forceinline__ void st2_bf16(bf16_t* p, int p8, const u32x4 A, const u32x4 B, bool lo, bool dry = false) { f32x4 s1, s2; rowpair(__builtin_bit_cast(f32x4, A), __builtin_bit_cast(f32x4, B), lo, s1, s2);
    if (MK_EXPG == 6 && dry) { keep4(s1); keep4(s2); asm volatile("" :: "v"(p)); return; }
    *(u32x4*)p = __builtin_bit_cast(u32x4, s1); *(u32x4*)(p + p8) = __builtin_bit_cast(u32x4, s2); }
template <bool NT> __device__ __forceinline__ void st2_f32(float* p, int p8, const f32x4 A, const f32x4 B, bool lo, bool dry = false) { f32x4 s1, s2; rowpair(A, B, lo, s1, s2);
    if (MK_EXPG == 6 && dry) { keep4(s1); keep4(s2); asm volatile("" :: "v"(p)); return; }
    if (NT) { __builtin_nontemporal_store(s1, (f32x4*)p); __builtin_nontemporal_store(s2, (f32x4*)(p + p8)); } else { *(f32x4*)p = s1; *(f32x4*)(p + p8) = s2; } }
__device__ __forceinline__ void rope8(const float* tab64, int row, int fq, const f32x4 x1a, const f32x4 x2a, const f32x4 x1b, const f32x4 x2b, f32x4& a1, f32x4& a2, f32x4& b1, f32x4& b2) {
    const float* tp = tab64 + ((size_t)pos_index_(row) * 32 + 8 * fq) * 2;
    const f32x4 c0 = *(const f32x4*)tp, c1 = *(const f32x4*)(tp + 4), c2 = *(const f32x4*)(tp + 8), c3 = *(const f32x4*)(tp + 12);
    rope4(x1a, x2a, c0, c1, a1, a2); rope4(x1b, x2b, c2, c3, b1, b2);
}
struct EpiAIn {
    static constexpr bool PERM = false, AFTER_DRAIN = false;
    bf16_t *QA, *KA, *VA, *GA; float *okp, *oks, *ovp, *ovs; const float* tab64; float qscale; int xskip = 0;
    __device__ __forceinline__ void operator()(const f32x4 (&acc)[2][2][4][2], const Unit& u, int wr, int wc, int fr, int fq) const {
        const int T = u.pn, type = T >> 3; const bool lo = fr < 8;
        if (MK_EXPG && MK_EXPG != 6 && xskip) return; const bool dry = MK_EXPG == 6 && xskip;
        const int cw = (T & 7) * 256 + 64 * wc + 8 * fq;
#pragma unroll
        for (int ai = 0; ai < 2; ++ai)
#pragma unroll
            for (int m = 0; m < 4; ++m) {
                const int rowb = u.pm * BM + ai * HALF + wr * 64 + m * 16, row0 = rowb + (fr & 7); const size_t ro0 = (size_t)row0 * 2048;
                float* f0 = row0 < 8192 ? (type == 1 ? okp : ovp) + ro0 : (type == 1 ? oks : ovs) + (ro0 - (size_t)8192 * 2048);
                if (type < 2) {
                    f32x4 a1, a2, b1, b2; rope8(tab64, rowb + fr, fq, acc[ai][0][m][0], acc[ai][1][m][0], acc[ai][0][m][1], acc[ai][1][m][1], a1, a2, b1, b2);
                    if (type == 0) { a1 = a1 * qscale; a2 = a2 * qscale; b1 = b1 * qscale; b2 = b2 * qscale; }
                    st2_bf16((type == 0 ? QA : KA) + ro0 + cw + (lo ? 0 : 32), 8 * 2048, pack8(a1, b1), pack8(a2, b2), lo, dry);
                    if (type == 1) { st2_f32<true>(f0 + cw + (lo ? 0 : 4), 8 * 2048, a1, b1, lo, dry); st2_f32<true>(f0 + cw + 32 + (lo ? 0 : 4), 8 * 2048, a2, b2, lo, dry); }
                } else if (type == 2) {
                    st2_bf16(VA + ro0 + cw + (lo ? 0 : 32), 8 * 2048, pack8(acc[ai][0][m][0], acc[ai][0][m][1]), pack8(acc[ai][1][m][0], acc[ai][1][m][1]), lo, dry);
                    st2_f32<true>(f0 + cw + (lo ? 0 : 4), 8 * 2048, acc[ai][0][m][0], acc[ai][0][m][1], lo, dry); st2_f32<true>(f0 + cw + 32 + (lo ? 0 : 4), 8 * 2048, acc[ai][1][m][0], acc[ai][1][m][1], lo, dry);
                } else {
                    st2_bf16(GA + ro0 + cw + (lo ? 0 : 32), 8 * 2048, pack8(silu4(acc[ai][0][m][0]), silu4(acc[ai][0][m][1])), pack8(silu4(acc[ai][1][m][0]), silu4(acc[ai][1][m][1])), lo, dry);
                }
            }
    }
};
struct EpiBIn {
    static constexpr bool PERM = false, AFTER_DRAIN = false;
    bf16_t *QB, *KB, *VB, *QI, *KI, *GB; float* WI; float *okp, *oks, *ovp, *ovs, *oip, *ois; const float *tab64, *tab128; float qscale;
    int xskip = 0;
    __device__ __forceinline__ void operator()(const f32x4 (&acc)[2][2][4][2], const Unit& u, int wr, int wc, int fr, int fq) const { if (MK_EXPG == 5 && xskip) return;
        const int T = u.pn;
#pragma unroll
        for (int ai = 0; ai < 2; ++ai)
#pragma unroll
            for (int m = 0; m < 4; ++m) {
                const int row = u.pm * BM + ai * HALF + wr * 64 + m * 16 + fr; const bool pr = row < 8192; const int rs = row - 8192; const int pidx = pos_index_(row);
                if (T < 10) {
                    const int i64 = 16 * wc + 4 * fq; const float* tp = tab128 + ((size_t)pidx * 64 + i64) * 2; const f32x4 csa = *(const f32x4*)tp, csb = *(const f32x4*)(tp + 4);
#pragma unroll
                    for (int bj = 0; bj < 2; ++bj) { f32x4 o1, o2; rope4(acc[ai][bj][m][0], acc[ai][bj][m][1], csa, csb, o1, o2);
                        if (T < 8) { const int col = T * 256 + bj * HALF + i64; o1 = o1 * qscale; o2 = o2 * qscale; *(u32x2*)(QB + (size_t)row * 2048 + col) = pack4(o1); *(u32x2*)(QB + (size_t)row * 2048 + col + 64) = pack4(o2); }
                        else { const int col = (T - 8) * 256 + bj * HALF + i64; *(u32x2*)(KB + (size_t)row * 512 + col) = pack4(o1); *(u32x2*)(KB + (size_t)row * 512 + col + 64) = pack4(o2);
                            float* f = pr ? okp + (size_t)row * 512 : oks + (size_t)rs * 512; *(f32x4*)(f + col) = o1; *(f32x4*)(f + col + 64) = o2; } }
                } else if (T < 12) {
                    const int cw = (T - 10) * 256 + 64 * wc + 8 * fq; const bool lo = fr < 8; const int row0 = row - fr + (fr & 7); float* f0 = pr ? ovp + (size_t)row0 * 512 : ovs + (size_t)(row0 - 8192) * 512;
                    st2_bf16(VB + (size_t)row0 * 512 + cw + (lo ? 0 : 32), 8 * 512, pack8(acc[ai][0][m][0], acc[ai][0][m][1]), pack8(acc[ai][1][m][0], acc[ai][1][m][1]), lo);
                    st2_f32<false>(f0 + cw + (lo ? 0 : 4), 8 * 512, acc[ai][0][m][0], acc[ai][0][m][1], lo); st2_f32<false>(f0 + cw + 32 + (lo ? 0 : 4), 8 * 512, acc[ai][1][m][0], acc[ai][1][m][1], lo);
                } else if (T < 16) {
                    const int cw = (T - 12) * 256 + 64 * wc + 8 * fq; const bool lo = fr < 8; const int row0 = row - fr + (fr & 7);
                    f32x4 a1, a2, b1, b2; rope8(tab64, row, fq, acc[ai][0][m][0], acc[ai][1][m][0], acc[ai][0][m][1], acc[ai][1][m][1], a1, a2, b1, b2);
                    st2_bf16(QI + (size_t)row0 * 1024 + cw + (lo ? 0 : 32), 8 * 1024, pack8(a1, b1), pack8(a2, b2), lo);
                } else if (T == 16) {
                    if (wc < 2) { const int i32 = 16 * (wc & 1) + 4 * fq; const float* tp = tab64 + ((size_t)pidx * 32 + i32) * 2; const f32x4 csa = *(const f32x4*)tp, csb = *(const f32x4*)(tp + 4);
                        f32x4 o1, o2; rope4(acc[ai][0][m][0], acc[ai][0][m][1], csa, csb, o1, o2);
                        *(u32x2*)(KI + (size_t)row * 64 + i32) = pack4(o1); *(u32x2*)(KI + (size_t)row * 64 + i32 + 32) = pack4(o2);
                        float* f = pr ? oip + (size_t)row * 64 : ois + (size_t)rs * 64; *(f32x4*)(f + i32) = o1; *(f32x4*)(f + i32 + 32) = o2; }
                    else if (wc == 2) { *(f32x4*)(WI + (size_t)row * 16 + 4 * fq) = acc[ai][0][m][0] * 0.25f; }
                } else {
                    const int cw = (T - 17) * 256 + 64 * wc + 8 * fq; const bool lo = fr < 8; const int row0 = row - fr + (fr & 7);
                    st2_bf16(GB + (size_t)row0 * 2048 + cw + (lo ? 0 : 32), 8 * 2048, pack8(silu4(acc[ai][0][m][0]), silu4(acc[ai][0][m][1])), pack8(silu4(acc[ai][1][m][0]), silu4(acc[ai][1][m][1])), lo);
                }
            }
    }
};
__device__ __forceinline__ float tanh_fast(float x) { const float e = __expf(2.f * x); return 1.f - 2.f * __builtin_amdgcn_rcpf(e + 1.f); }
struct EpiC1 {
    static constexpr bool PERM = false, AFTER_DRAIN = false;
    float* RKVG; bf16_t* XL; size_t md;
    int xskip = 0;
    __device__ __forceinline__ void operator()(const f32x4 (&acc)[2][2][4][2], const Unit& u, int wr, int wc, int fr, int fq) const { if (MK_EXPG == 5 && xskip) return;
        const int pn = u.pn, pmt = u.pm % 34;
#pragma unroll
        for (int ai = 0; ai < 2; ++ai)
#pragma unroll
            for (int m = 0; m < 4; ++m) {
                const int row = pmt * BM + ai * HALF + wr * 64 + m * 16 + fr;
                if (pn < 32) { const bool lo = fr < 8; float* dst = RKVG + (size_t)(pn >> 3) * md + (size_t)(row - fr + (fr & 7)) * 2048 + (pn & 7) * 256 + 32 * wc + (lo ? 0 : 16) + 4 * fq;
#pragma unroll
                    for (int bj = 0; bj < 2; ++bj) { f32x4 s1, s2; rowpair(acc[ai][bj][m][0], acc[ai][bj][m][1], lo, s1, s2);
                        __builtin_nontemporal_store(s1, (f32x4*)(dst + bj * HALF)); __builtin_nontemporal_store(s2, (f32x4*)(dst + bj * HALF + 8 * 2048)); }
                } else {
#pragma unroll
                    for (int n = 0; n < 2; ++n) { f32x4 v = acc[ai][0][m][n]; if (pn == 32) v = (f32x4){tanh_fast(v[0]), tanh_fast(v[1]), tanh_fast(v[2]), tanh_fast(v[3])};
                        *(u32x2*)(XL + (size_t)row * 256 + (pn - 32) * 128 + 32 * wc + 16 * n + 4 * fq) = pack4(v); }
                }
            }
    }
};
struct EpiC2 {
    static constexpr bool PERM = false, AFTER_DRAIN = false;
    float *DEC, *AS; const float *w0, *a0;
    int xskip = 0;
    __device__ __forceinline__ void operator()(const f32x4 (&acc)[2][2][4][2], const Unit& u, int wr, int wc, int fr, int fq) const { if (MK_EXPG == 5 && xskip) return;
        const int pn = u.pn; const bool isw = pn < 8; float* dst = isw ? DEC : AS; const float* bias = isw ? w0 : a0;
#pragma unroll
        for (int ai = 0; ai < 2; ++ai)
#pragma unroll
            for (int m = 0; m < 4; ++m) { const bool lo = fr < 8; const int row0 = u.pm * BM + ai * HALF + wr * 64 + m * 16 + (fr & 7); float* drow = dst + (size_t)row0 * 2048;
#pragma unroll
                for (int bj = 0; bj < 2; ++bj) { f32x4 sx[2]; rowpair(acc[ai][bj][m][0], acc[ai][bj][m][1], lo, sx[0], sx[1]);
                    const int col = (pn & 7) * 256 + bj * HALF + 32 * wc + (lo ? 0 : 16) + 4 * fq; const f32x4 bb = *(const f32x4*)(bias + col);
#pragma unroll
                    for (int h = 0; h < 2; ++h) { const f32x4 x = sx[h] + bb; f32x4 o;
#pragma unroll
                        for (int e = 0; e < 4; ++e) { const float sg = __builtin_amdgcn_rcpf(1.f + __expf(-x[e])); o[e] = isw ? __expf(-0.6065306597126334f * sg) : sg; }
                        __builtin_nontemporal_store(o, (f32x4*)(drow + (size_t)h * 8 * 2048 + col)); } }
                asm volatile("" ::: "memory"); }
    }
};
struct EpiOut {
    static constexpr bool PERM = false, AFTER_DRAIN = false;
    const float* xp; float* XR; float* PART;
    int xskip = 0;
    __device__ __forceinline__ void operator()(const f32x4 (&acc)[2][2][4][2], const Unit& u, int wr, int wc, int fr, int fq) const { if (MK_EXPG == 5 && xskip) return;
        const bool samp = u.pm >= 32; float* pbase = PART + (size_t)(u.k0 >> 8) * 512 * 2048;
#pragma unroll
        for (int ai = 0; ai < 2; ++ai)
#pragma unroll
            for (int m = 0; m < 4; ++m) { const bool lo = fr < 8; const int row = u.pm * BM + ai * HALF + wr * 64 + m * 16 + (fr & 7); const float* b = xp + (size_t)row * 2048; float* o = samp ? pbase + (size_t)(row - 8192) * 2048 : XR + (size_t)row * 2048;
#pragma unroll
                for (int bj = 0; bj < 2; ++bj) { f32x4 s1, s2; rowpair(acc[ai][bj][m][0], acc[ai][bj][m][1], lo, s1, s2); const int col = u.pn * BM + bj * HALF + 32 * wc + (lo ? 0 : 16) + 4 * fq;
                    if (!samp) { s1 = s1 + *(const f32x4*)(b + col); s2 = s2 + *(const f32x4*)(b + 8 * 2048 + col); } *(f32x4*)(o + col) = s1; *(f32x4*)(o + 8 * 2048 + col) = s2; } }
    }
};
struct OutOrder {
    StaticOrder S; int G, c;
    __device__ __forceinline__ void init(int G_, int c_) { S.init(8192, 2048, G_, c_); G = G_; c = c_; }
    __device__ __forceinline__ bool next(int i, Unit& u) const { const int L = i * G + c; if (L < 256) return S.next(i, u); const int it = L - 256; if (it >= 128) return false;
        u.pm = 32 + (it >> 6); u.pn = (it >> 3) & 7; u.k0 = (it & 7) * 256; u.nt = 4; return true; }
    __device__ __forceinline__ void a_ready(const Unit&) const {}
    __device__ __forceinline__ void done(const Unit&) const {}
};
struct COrder {
    int G, c;
    __device__ __forceinline__ bool next(int i, Unit& u) const { const int L = i * G + c; if (L >= 34 * 34) return false; const int pn = L / 34, pmt = L % 34; const int nl = pn < 32 ? (pn >> 3) : (pn - 28); u.pm = nl * 34 + pmt; u.pn = pn; return true; }
    __device__ __forceinline__ void a_ready(const Unit&) const {}
    __device__ __forceinline__ void done(const Unit&) const {}
};
}
#define XB_TMO      128
#define XB_XCNT(j)  (256  + 64 * (j))
#define XB_XSUB(j)  (1280 + 64 * (j))
#define XB_XGEN(j)  (2304 + 64 * (j))
#define XB_TOP      3328
#define XB_TOPGEN   3392
#define XCD_BAR_WORDS 3456
#define XB_SPIN_CAP (1u << 18)

__device__ __forceinline__ unsigned xb_ld(unsigned* p)              { return __hip_atomic_load(p, __ATOMIC_RELAXED, __HIP_MEMORY_SCOPE_AGENT); }
__device__ __forceinline__ unsigned xb_add(unsigned* p, unsigned v) { return __hip_atomic_fetch_add(p, v, __ATOMIC_RELAXED, __HIP_MEMORY_SCOPE_AGENT); }
__device__ __forceinline__ unsigned xb_xcc_id() { return (unsigned)__builtin_amdgcn_s_getreg((3 << 11) | 20) & 0xFu; }
#define XB_SPIN(cond, bar) do { unsigned _sp = 0; while (cond) { __builtin_amdgcn_s_sleep(1); \
    if ((++_sp & 255u) == 0u) { if (xb_ld(&(bar)[XB_TMO])) break; if (_sp > XB_SPIN_CAP) { atomicAdd(&(bar)[XB_TMO], 1u); break; } } } } while (0)

struct XcdBarrier {
    unsigned* bar; unsigned x;
    volatile LAS unsigned* st;
};

__device__ __forceinline__ XcdBarrier xcd_barrier_post(unsigned* bar, volatile LAS unsigned* st) {
    XcdBarrier b; b.bar = bar; b.x = xb_xcc_id(); b.st = st;
    if (threadIdx.x == 0) (void)xb_add(&bar[XB_XCNT(b.x)], 1u);
    return b;
}
__device__ __forceinline__ void xcd_barrier_complete(unsigned* bar, unsigned x, unsigned& nloc, unsigned& nx) {
    const unsigned G = gridDim.x * gridDim.y * gridDim.z;
    unsigned sum, cnt, mine, sp = 0u;
    for (;;) {
        sum = 0u; cnt = 0u; mine = 0u;
#pragma unroll
        for (unsigned j = 0; j < 16; ++j) { const unsigned c = xb_ld(&bar[XB_XCNT(j)]); sum += c; cnt += (c > 0u) ? 1u : 0u; mine = (j == x) ? c : mine; }
        if (sum == G) break;
        __builtin_amdgcn_s_sleep(1);
        if ((++sp & 255u) == 0u) { if (xb_ld(&bar[XB_TMO])) break; if (sp > XB_SPIN_CAP) { atomicAdd(&bar[XB_TMO], 1u); break; } }
    }
    nloc = mine > 0u ? mine : 1u; nx = cnt > 0u ? cnt : 1u;
}

__device__ __forceinline__ void xcd_barrier(const XcdBarrier& b) {
    asm volatile("s_waitcnt vmcnt(0)" ::: "memory");
    __syncthreads();
    if (threadIdx.x == 0) {
        unsigned* bar = b.bar;
        __builtin_amdgcn_s_waitcnt(0);
        unsigned nloc = b.st[0], nx = b.st[1];
        if (nloc == 0u) { xcd_barrier_complete(bar, b.x, nloc, nx); b.st[0] = nloc; b.st[1] = nx; }
        const unsigned old = xb_add(&bar[XB_XSUB(b.x)], 1u);
        const unsigned gen = old / nloc;
        if (old + 1u == (gen + 1u) * nloc) {
            __builtin_amdgcn_fence(__ATOMIC_RELEASE, "agent");
            asm volatile("s_waitcnt vmcnt(0)" ::: "memory");
            const unsigned og = xb_add(&bar[XB_TOP], 1u);
            const unsigned tg = og / nx;
            if (og + 1u == (tg + 1u) * nx) xb_add(&bar[XB_TOPGEN], 1u);
            else XB_SPIN(xb_ld(&bar[XB_TOPGEN]) == tg, bar);
            __builtin_amdgcn_fence(__ATOMIC_ACQUIRE, "agent");
            xb_add(&bar[XB_XGEN(b.x)], 1u);
            asm volatile("s_waitcnt vmcnt(0)" ::: "memory");
        } else {
            XB_SPIN(xb_ld(&bar[XB_XGEN(b.x)]) == gen, bar);
            __builtin_amdgcn_fence(__ATOMIC_ACQUIRE, "agent");
            asm volatile("s_waitcnt vmcnt(0)" ::: "memory");
        }
    }
    __syncthreads();
}
constexpr int KSTR = 256, VSTR = 256, KBUF = 64 * KSTR, VBUF = 64 * VSTR, STAGEB = KBUF + VBUF;
__device__ __forceinline__ int kswz(int r) { return r & 15; }
__device__ __forceinline__ int vswz(int r) { return ((r & 3) << 2) | ((r >> 2) & 3); }
static_assert(4 * STAGEB <= RING_BYTES && 4 * 64 * 64 * 4 <= RING_BYTES, "attention LDS");
typedef short v4i16_t __attribute__((ext_vector_type(4)));
__device__ __forceinline__ s16x4 vtr(const LAS char* p) { return __builtin_bit_cast(s16x4, __builtin_amdgcn_ds_read_tr16_b64_v4i16((LAS v4i16_t*)p)); }
__device__ __forceinline__ int crow(int r, int hi) { return (r & 3) + 8 * (r >> 2) + 4 * hi; }

struct TileSrc { const char* k; const char* v; int ldb; int f32; };
template <class T> __device__ __forceinline__ T gld(const char* ubase, unsigned off) { return *(const GAS T*)((const GAS char*)ubase + off); }
__device__ __forceinline__ void half_load(const TileSrc& s, int which, int tid, v4u (&raw)[4]) {
    const char* base = which ? s.v : s.k; asm volatile("" : "+v"(tid));
#pragma unroll
    for (int i = 0; i < 2; ++i) { const unsigned p = tid + 512 * i, row = p >> 4, cg = p & 15;
        if (s.f32) { const unsigned o = row * (unsigned)s.ldb + cg * 32u; raw[2 * i] = gld<v4u>(base, o); raw[2 * i + 1] = gld<v4u>(base, o + 16u); }
        else raw[2 * i] = gld<v4u>(base, row * (unsigned)s.ldb + cg * 16u); }
}
__device__ __forceinline__ float u2f(unsigned u) { return __builtin_bit_cast(float, u); }
__device__ __forceinline__ v4u cvt8(const v4u a, const v4u b) { v4u o; o.x = cvtpk(u2f(a.x), u2f(a.y)); o.y = cvtpk(u2f(a.z), u2f(a.w)); o.z = cvtpk(u2f(b.x), u2f(b.y)); o.w = cvtpk(u2f(b.z), u2f(b.w)); return o; }
__device__ __forceinline__ void half_store(LAS unsigned char* buf, int which, int f32, int tid, const v4u (&raw)[4]) {
    asm volatile("" : "+v"(tid));
#pragma unroll
    for (int i = 0; i < 2; ++i) { const int p = tid + 512 * i, row = p >> 4, cg = p & 15;
        const v4u x = f32 ? cvt8(raw[2 * i], raw[2 * i + 1]) : raw[2 * i];
        if (which) *(LAS v4u*)(buf + KBUF + row * VSTR + ((cg ^ vswz(row)) << 4)) = x; else *(LAS v4u*)(buf + row * KSTR + ((cg ^ kswz(row)) << 4)) = x; }
}

struct AttnUnit {
    int qrow0;
    int ntiles;
    int samp, b, head;
    int qb;
    int dual, head2;
    int cv;
    int t0, split;
};

template <int LAYER>
__device__ __forceinline__ TileSrc tile_src(const Frame& F, const AttnUnit& u, int t, int j) {
    TileSrc s;
    if (LAYER == 0) {
        const bf16* KA = (const bf16*)(F.ws + WS_KA); const bf16* VA = (const bf16*)(F.ws + WS_VA);
        if (!u.samp) { const size_t o = ((size_t)(u.b * TP + 64 * t) * D + u.head * 128) * 2; s.k = (const char*)KA + o; s.v = (const char*)VA + o; s.ldb = D * 2; s.f32 = 0; }
        else if (t < 64 && u.cv) { const size_t o = ((((size_t)u.b * PAST + 64 * t) * 16 + u.head) * 128) * 2; s.k = (const char*)(F.ws + WS_KC) + o; s.v = (const char*)(F.ws + WS_VC) + o; s.ldb = D * 2; s.f32 = 0; }
        else if (t < 64) { const size_t o = ((((size_t)(j * 8 + u.b) * PAST + 64 * t) * 16 + u.head) * 128) * 4; s.k = (const char*)F.a->in[2] + o; s.v = (const char*)F.a->in[3] + o; s.ldb = D * 4; s.f32 = 1; }
        else { const size_t o = ((size_t)(NP + u.b * TS) * D + u.head * 128) * 2; s.k = (const char*)KA + o; s.v = (const char*)VA + o; s.ldb = D * 2; s.f32 = 0; }
    } else {
        const bf16* KB = (const bf16*)(F.ws + WS_KB); const bf16* VB = (const bf16*)(F.ws + WS_VB);
        if (!u.samp) { const size_t o = ((size_t)(u.b * TP + 64 * t) * 512 + u.head * 128) * 2; s.k = (const char*)KB + o; s.v = (const char*)VB + o; s.ldb = 512 * 2; s.f32 = 0; }
        else if (t < 64) { const size_t o = ((((size_t)u.b * PAST + 64 * t) * 4 + u.head) * 128) * 4; s.k = (const char*)F.a->in[4] + o; s.v = (const char*)F.a->in[5] + o; s.ldb = 512 * 4; s.f32 = 1; }
        else { const size_t o = ((size_t)(NP + u.b * TS) * 512 + u.head * 128) * 2; s.k = (const char*)KB + o; s.v = (const char*)VB + o; s.ldb = 512 * 2; s.f32 = 0; }
    }
    return s;
}

constexpr int MSKB = 512, STG2 = 2 * STAGEB + 2 * MSKB;
static_assert(2 * STG2 <= MISC_OFF, "attention DMA stages");
#ifndef MK_EXP
#define MK_EXP 0
#endif
#ifndef MK_EXPS
#define MK_EXPS 0
#endif
template <int LAYER, bool DMA>
__device__ __forceinline__ void attn_unit(Frame& F, const AttnUnit& u, int j, float lam, float lam_init, int xmode = 0) {
    constexpr int NKS = LAYER == 0 ? 4 : 8;
    int tid = F.tid; asm volatile("" : "+v"(tid));
    const int lane = tid & 63, w = F.wave, r32 = lane & 31, hi = lane >> 5, L = lane & 15;
    const int map = LAYER == 0 ? (w >> 2) : 0, sb = LAYER == 0 ? (w & 3) : (w >> 2), r4 = w & 3;
    const bool dual = LAYER == 0 && u.dual; const int hsel = dual ? (sb >> 1) : 0, sbr = dual ? (sb & 1) : sb, myhead = hsel ? u.head2 : u.head;
    const bool active = LAYER == 0 ? (u.samp ? (dual || sb < 2) : true) : true;
    const int my_last = LAYER == 0 ? (u.samp ? 64 : 2 * u.qb + (sb >> 1)) : u.ntiles - 1;
    const int qrow = u.qrow0 + 32 * sbr + r32;
    const int hcol = LAYER == 0 ? myhead * 128 : (u.head * 4 + r4) * 128;
    const int koff = LAYER == 0 ? map * 64 : 0;
    bf16x8 qf[NKS];
    { const bf16* Q = (const bf16*)(F.ws + (LAYER == 0 ? WS_QA : WS_QB)) + (size_t)(active ? qrow : u.qrow0) * D + hcol + koff + 8 * hi;
#pragma unroll
      for (int ks = 0; ks < NKS; ++ks) qf[ks] = *(const GAS bf16x8*)(Q + 16 * ks); }
    const char* mbase = (const char*)(F.ws + WS_MASK); const unsigned moff = (unsigned)qrow * (MASKW * 4u);
    f32x16 o[4];
#pragma unroll
    for (int d = 0; d < 4; ++d)
#pragma unroll
        for (int r = 0; r < 16; ++r) o[d][r] = 0.f;
    float mrun = -1e30f, lrun = 0.f;
    LAS unsigned char* lds = F.lds;
    const int Lq = L >> 2, vlane = (4 * hi + Lq) * VSTR + 8 * (L & 1);
    int voff[4][2];
#pragma unroll
    for (int d = 0; d < 4; ++d)
#pragma unroll
        for (int jj = 0; jj < 2; ++jj) voff[d][jj] = ((((d ^ Lq) << 2) | ((2 * ((lane >> 4) & 1) + ((L & 3) >> 1)) ^ (2 * jj + hi))) << 4);
    const int ksw = r32 & 15;
    v4u raw[4];
    const int T0 = u.t0;
    const LAS unsigned char* vb = nullptr;
#define ATT_VREAD(dst, q_) do { const LAS char* vp_ = (const LAS char*)vb + (((q_) >> 1) * 32 + 16 * ((q_) & 1)) * VSTR; \
        _Pragma("unroll") for (int d_ = 0; d_ < 4; ++d_) { dst[d_][0] = vtr(vp_ + voff[d_][0]); dst[d_][1] = vtr(vp_ + 8 * VSTR + voff[d_][1]); } } while (0)
#define ATT_PV(src, pb_, q_) do { _Pragma("unroll") for (int d_ = 0; d_ < 4; ++d_) { const s16x4 lo_ = src[d_][0], hh_ = src[d_][1]; \
        const bf16x8 vf_ = (bf16x8){lo_[0], lo_[1], lo_[2], lo_[3], hh_[0], hh_[1], hh_[2], hh_[3]}; o[d_] = __builtin_amdgcn_mfma_f32_32x32x16_bf16(vf_, pb_[(q_) >> 1][(q_) & 1], o[d_], 0, 0, 0); } } while (0)
    auto QK = [&](const LAS unsigned char* sbase, f32x16& s0, f32x16& s1) {
        const LAS unsigned char* kb = sbase + r32 * KSTR; const int kc0 = (koff >> 3) + hi;
#pragma unroll
        for (int r = 0; r < 16; ++r) { s0[r] = 0.f; s1[r] = 0.f; }
#pragma unroll
        for (int kh = 0; kh < NKS; kh += 4) {
            bf16x8 ka[4][2];
#pragma unroll
            for (int ks = 0; ks < 4; ++ks) { const int ko = ((kc0 + 2 * (kh + ks)) ^ ksw) << 4; ka[ks][0] = *(const LAS bf16x8*)(kb + ko); ka[ks][1] = *(const LAS bf16x8*)(kb + 32 * KSTR + ko); }
            __builtin_amdgcn_s_setprio(1);
#pragma unroll
            for (int ks = 0; ks < 4; ++ks) { s0 = __builtin_amdgcn_mfma_f32_32x32x16_bf16(ka[ks][0], qf[kh + ks], s0, 0, 0, 0); s1 = __builtin_amdgcn_mfma_f32_32x32x16_bf16(ka[ks][1], qf[kh + ks], s1, 0, 0, 0); }
            __builtin_amdgcn_s_setprio(0);
        }
    };
    auto SM = [&](unsigned w0, unsigned w1, f32x16& s0, f32x16& s1, bf16x8 (&pb)[2][2]) {
        if (LAYER == 1) {
#pragma unroll
            for (int r = 0; r < 16; ++r) { const int kv = crow(r, hi); if (!((w0 >> kv) & 1u)) s0[r] = -1e30f; if (!((w1 >> kv) & 1u)) s1[r] = -1e30f; } }
        float mx = fmaxf(s0[0], s1[0]);
#pragma unroll
        for (int r = 1; r < 16; ++r) mx = fmaxf(mx, fmaxf(s0[r], s1[r]));
        mx = fmaxf(mx, __shfl_xor(mx, 32));
        const bool need = mx > mrun + 8.f;
        if (__any(need)) { const float mnew = need ? mx : mrun, alpha = __builtin_amdgcn_exp2f(mrun - mnew); mrun = mnew; lrun *= alpha;
#pragma unroll
            for (int d = 0; d < 4; ++d)
#pragma unroll
                for (int r = 0; r < 16; ++r) o[d][r] *= alpha; }
        float rsa[4] = {0.f, 0.f, 0.f, 0.f};
#pragma unroll
        for (int r = 0; r < 16; ++r) { float p0 = __builtin_amdgcn_exp2f(s0[r] - mrun), p1 = __builtin_amdgcn_exp2f(s1[r] - mrun);
            if (LAYER == 1) { const int kv = crow(r, hi); p0 = ((w0 >> kv) & 1u) ? p0 : 0.f; p1 = ((w1 >> kv) & 1u) ? p1 : 0.f; }
            s0[r] = p0; s1[r] = p1; rsa[r & 3] += p0 + p1; }
        lrun += (rsa[0] + rsa[1]) + (rsa[2] + rsa[3]);
#pragma unroll
        for (int s = 0; s < 2; ++s) {
            v4u x; x.x = cvtpk(s0[8 * s + 0], s0[8 * s + 1]); x.y = cvtpk(s0[8 * s + 2], s0[8 * s + 3]); x.z = cvtpk(s0[8 * s + 4], s0[8 * s + 5]); x.w = cvtpk(s0[8 * s + 6], s0[8 * s + 7]); pb[0][s] = __builtin_bit_cast(bf16x8, x);
            v4u y; y.x = cvtpk(s1[8 * s + 0], s1[8 * s + 1]); y.y = cvtpk(s1[8 * s + 2], s1[8 * s + 3]); y.z = cvtpk(s1[8 * s + 4], s1[8 * s + 5]); y.w = cvtpk(s1[8 * s + 6], s1[8 * s + 7]); pb[1][s] = __builtin_bit_cast(bf16x8, y); }
    };
    AttnUnit u2 = u; u2.head = u.head2;
    if constexpr (DMA) {
#define ATT_ISSUE1(un_, t_, sb_) do { const TileSrc sd_ = tile_src<LAYER>(F, un_, (t_), j); \
        _Pragma("unroll") for (int i_ = 0; i_ < 2; ++i_) { const int ins_ = 2 * w + i_, row_ = 4 * ins_ + (lane >> 4), p_ = lane & 15; \
            __builtin_amdgcn_global_load_lds((const GAS unsigned*)(sd_.k + (size_t)row_ * sd_.ldb + ((p_ ^ kswz(row_)) << 4)), (LAS unsigned*)((sb_) + ins_ * 1024), 16, 0, 0); \
            __builtin_amdgcn_global_load_lds((const GAS unsigned*)(sd_.v + (size_t)row_ * sd_.ldb + ((p_ ^ vswz(row_)) << 4)), (LAS unsigned*)((sb_) + KBUF + ins_ * 1024), 16, 0, 0); } } while (0)
#define ATT_ISSUEM(t_, mb_) do { if (LAYER == 1 && w < 2) __builtin_amdgcn_global_load_lds((const GAS unsigned*)(mbase + (size_t)(u.qrow0 + 32 * w + (lane >> 1)) * (MASKW * 4) + (2 * (t_) + (lane & 1)) * 4), (LAS unsigned*)((mb_) + w * 256), 4, 0, 0); } while (0)
#define ATT_ISSUE2(p_, st_) do { LAS unsigned char* sp_ = lds + (st_) * STG2; const int ta_ = dual ? (p_) : 2 * (p_), tb_ = dual ? (p_) : 2 * (p_) + 1; ATT_ISSUE1(u, ta_, sp_); ATT_ISSUEM(ta_, sp_ + 2 * STAGEB); \
        if (dual || tb_ < u.ntiles) { ATT_ISSUE1(ub, tb_, sp_ + STAGEB); ATT_ISSUEM(tb_, sp_ + 2 * STAGEB + MSKB); } } while (0)
        const AttnUnit& ub = dual ? u2 : u;
        const int npairs = dual ? u.ntiles : (u.ntiles + 1) >> 1, p0 = dual ? T0 : T0 >> 1;
        ATT_ISSUE2(p0, p0 & 1);
        for (int p = p0; p < npairs; ++p) {
            asm volatile("s_waitcnt vmcnt(0)" ::: "memory");
            __builtin_amdgcn_s_barrier(); asm volatile("" ::: "memory");
            if (p + 1 < npairs) ATT_ISSUE2(p + 1, (p + 1) & 1);
            LAS unsigned char* const sa = lds + (p & 1) * STG2; LAS unsigned char* const sbb = sa + STAGEB;
            const int ta = dual ? p : 2 * p, tb = dual ? p : 2 * p + 1;
            const bool wka = active && !(dual && hsel) && ta <= my_last && !(xmode & 1), wkb = active && !(dual && !hsel) && tb < u.ntiles && tb <= my_last && !(xmode & 1);
            f32x16 a0, a1, b0, b1; bf16x8 pba[2][2], pbb[2][2]; s16x4 vpre[4][2], va[4][2], vbb[4][2];
            unsigned wa0 = 0xffffffffu, wa1 = 0xffffffffu, wb0 = 0xffffffffu, wb1 = 0xffffffffu;
            if (LAYER == 1) { const v2u ma = *(const LAS v2u*)(sa + 2 * STAGEB + (32 * sb + r32) * 8), mb = *(const LAS v2u*)(sa + 2 * STAGEB + MSKB + (32 * sb + r32) * 8); wa0 = ma.x; wa1 = ma.y; wb0 = mb.x; wb1 = mb.y; }
            if (wka) QK(sa, a0, a1);
            if (LAYER == 0) { if (wkb) QK(sbb, b0, b1); }
            if (wka) { vb = sa + KBUF + vlane; ATT_VREAD(vpre, 0); SM(wa0, wa1, a0, a1, pba);
                ATT_VREAD(va, 1); __builtin_amdgcn_s_setprio(1); ATT_PV(vpre, pba, 0); __builtin_amdgcn_s_setprio(0);
                ATT_VREAD(vbb, 2); __builtin_amdgcn_s_setprio(1); ATT_PV(va, pba, 1); __builtin_amdgcn_s_setprio(0);
                ATT_VREAD(va, 3); __builtin_amdgcn_s_setprio(1); ATT_PV(vbb, pba, 2); __builtin_amdgcn_s_setprio(0);
                __builtin_amdgcn_s_setprio(1); ATT_PV(va, pba, 3); __builtin_amdgcn_s_setprio(0); }
            if (LAYER == 1) { if (wkb) QK(sbb, b0, b1); }
            if (wkb) { vb = sbb + KBUF + vlane; ATT_VREAD(vpre, 0); SM(wb0, wb1, b0, b1, pbb);
                ATT_VREAD(va, 1); __builtin_amdgcn_s_setprio(1); ATT_PV(vpre, pbb, 0); __builtin_amdgcn_s_setprio(0);
                ATT_VREAD(vbb, 2); __builtin_amdgcn_s_setprio(1); ATT_PV(va, pbb, 1); __builtin_amdgcn_s_setprio(0);
                ATT_VREAD(va, 3); __builtin_amdgcn_s_setprio(1); ATT_PV(vbb, pbb, 2); __builtin_amdgcn_s_setprio(0);
                __builtin_amdgcn_s_setprio(1); ATT_PV(va, pbb, 3); __builtin_amdgcn_s_setprio(0); }
        }
#undef ATT_ISSUE1
#undef ATT_ISSUEM
#undef ATT_ISSUE2
        asm volatile("s_waitcnt lgkmcnt(0)" ::: "memory"); __builtin_amdgcn_s_barrier(); asm volatile("" ::: "memory");
    } else {
        const int SSTR = dual ? 2 * STAGEB : STAGEB; v4u raw2[4];
        { const TileSrc s0 = tile_src<LAYER>(F, u, T0, j); LAS unsigned char* fb = lds + (T0 & 1) * SSTR; half_load(s0, 0, tid, raw); half_store(fb, 0, s0.f32, tid, raw); half_load(s0, 1, tid, raw); half_store(fb, 1, s0.f32, tid, raw);
          if (dual) { const TileSrc s0b = tile_src<LAYER>(F, u2, T0, j); half_load(s0b, 0, tid, raw2); half_store(fb + STAGEB, 0, s0b.f32, tid, raw2); half_load(s0b, 1, tid, raw2); half_store(fb + STAGEB, 1, s0b.f32, tid, raw2); } }
        __syncthreads();
        for (int t = T0; t < u.ntiles; ++t) {
            const bool more = t + 1 < u.ntiles; TileSrc sn, snb; sn.f32 = 0; snb.f32 = 0;
            if (more) { sn = tile_src<LAYER>(F, u, t + 1, j); half_load(sn, 0, tid, raw); if (dual) { snb = tile_src<LAYER>(F, u2, t + 1, j); half_load(snb, 0, tid, raw2); } }
            LAS unsigned char* const sbase = lds + (t & 1) * SSTR + hsel * STAGEB; LAS unsigned char* const nb = lds + ((t + 1) & 1) * SSTR;
            const bool work = active && t <= my_last && !(xmode & 1);
            f32x16 s0, s1; bf16x8 pb[2][2];
            if (work) { QK(sbase, s0, s1); unsigned w0 = 0xffffffffu, w1 = 0xffffffffu; if (LAYER == 1) { const v2u mw = gld<v2u>(mbase, moff + 8u * t); w0 = mw.x; w1 = mw.y; } SM(w0, w1, s0, s1, pb); }
            if (more) { half_store(nb, 0, sn.f32, tid, raw); half_load(sn, 1, tid, raw); if (dual) { half_store(nb + STAGEB, 0, snb.f32, tid, raw2); half_load(snb, 1, tid, raw2); } }
            if (work) { vb = sbase + KBUF + vlane;
#pragma unroll
                for (int q = 0; q < 4; ++q) { s16x4 vcu[4][2]; ATT_VREAD(vcu, q); ATT_PV(vcu, pb, q); } }
            if (more) { half_store(nb, 1, sn.f32, tid, raw); if (dual) half_store(nb + STAGEB, 1, snb.f32, tid, raw2); }
            __syncthreads();
        }
    }
#undef ATT_VREAD
#undef ATT_PV
    const float ltot = lrun + __shfl_xor(lrun, 32);
    const float inv = active ? __builtin_amdgcn_rcpf(ltot) : 0.f;
    if (u.split >= 0) {
        if (active) { const int hd = LAYER == 0 ? myhead * 2 + map : u.head * 4 + r4;
            float* pr = (float*)(F.ws + WS_APART) + (((size_t)u.split * NS + (qrow - NP)) * 32 + hd) * 130;
#pragma unroll
            for (int d = 0; d < 4; ++d)
#pragma unroll
                for (int rg = 0; rg < 4; ++rg) { float* p = pr + d * 32 + 8 * rg + 4 * hi; p[0] = o[d][4 * rg]; p[1] = o[d][4 * rg + 1]; p[2] = o[d][4 * rg + 2]; p[3] = o[d][4 * rg + 3]; }
            if (hi == 0) { pr[128] = mrun; pr[129] = ltot; } }
        return;
    }
    bf16* OB = (bf16*)(F.ws + WS_OB);
    if (LAYER == 0) {
        LAS float* xch = (LAS float*)lds;
        if (map == 1 && active) { const float sc = inv * lam;
#pragma unroll
            for (int d = 0; d < 4; ++d)
#pragma unroll
                for (int r = 0; r < 16; ++r) xch[(sb * 64 + d * 16 + r) * 64 + lane] = o[d][r] * sc; }
        __syncthreads();
        if (map == 0 && active) {
            float ss = 0.f;
#pragma unroll
            for (int d = 0; d < 4; ++d)
#pragma unroll
                for (int r = 0; r < 16; ++r) { const float v = o[d][r] * inv - xch[(sb * 64 + d * 16 + r) * 64 + lane]; o[d][r] = v; ss += v * v; }
            ss += __shfl_xor(ss, 32);
            const float rsn = rsqrtf(ss * (1.f / 128.f) + 1e-5f) * (1.f - lam_init);
            const float* subg = F.a->in[14] + j * 128; const bf16* GA = (const bf16*)(F.ws + WS_GA) + (size_t)qrow * D + hcol; bf16* orow = OB + (size_t)qrow * D + hcol;
#pragma unroll
            for (int d = 0; d < 4; ++d)
#pragma unroll
                for (int rg = 0; rg < 4; ++rg) { const int dc = d * 32 + 8 * rg + 4 * hi; const f32x4 sg = *(const GAS f32x4*)(subg + dc); const v2u gg = *(const GAS v2u*)(GA + dc);
                    const float y0 = o[d][4 * rg + 0] * rsn * sg[0] * bf_lo(gg.x), y1 = o[d][4 * rg + 1] * rsn * sg[1] * bf_hi(gg.x), y2 = o[d][4 * rg + 2] * rsn * sg[2] * bf_lo(gg.y), y3 = o[d][4 * rg + 3] * rsn * sg[3] * bf_hi(gg.y);
                    v2u wv; wv.x = cvtpk(y0, y1); wv.y = cvtpk(y2, y3); *(GAS v2u*)(orow + dc) = wv; }
        }
        __syncthreads();
    } else {
        const bf16* GB = (const bf16*)(F.ws + WS_GB) + (size_t)qrow * D + hcol; bf16* orow = OB + (size_t)qrow * D + hcol;
#pragma unroll
        for (int d = 0; d < 4; ++d)
#pragma unroll
            for (int rg = 0; rg < 4; ++rg) { const int dc = d * 32 + 8 * rg + 4 * hi; const v2u gg = *(const GAS v2u*)(GB + dc);
                const float y0 = o[d][4 * rg + 0] * inv * bf_lo(gg.x), y1 = o[d][4 * rg + 1] * inv * bf_hi(gg.x), y2 = o[d][4 * rg + 2] * inv * bf_lo(gg.y), y3 = o[d][4 * rg + 3] * inv * bf_hi(gg.y);
                v2u wv; wv.x = cvtpk(y0, y1); wv.y = cvtpk(y2, y3); *(GAS v2u*)(orow + dc) = wv; }
    }
}

constexpr int CW_XRANK = 8192;
static_assert((CW_XRANK + 3 * 8 * 64) * 4 <= (int)CTL_ZERO_BYTES, "ctl rank words");
__device__ __forceinline__ int attn_slot(Frame& F, int phase_id) {
    unsigned* ctl = (unsigned*)(F.ws + WS_CTL); volatile LAS int* sh = (volatile LAS int*)(F.lds + MISC_OFF + 64);
    if (F.tid == 0) { int slot = F.bid;
        if (F.G == 256 && F.census != nullptr) { bool ok = true; for (int jx = 0; jx < 8; ++jx) ok = ok && (__hip_atomic_load(F.census + XB_XCNT(jx), __ATOMIC_RELAXED, __HIP_MEMORY_SCOPE_AGENT) == 32u);
            if (ok) { const unsigned x = xb_xcc_id() & 7u; const unsigned rk = __hip_atomic_fetch_add(ctl + CW_XRANK + (phase_id * 8 + (int)x) * 64, 1u, __ATOMIC_RELAXED, __HIP_MEMORY_SCOPE_AGENT); slot = (int)((rk & 31u) * 8u + x); } }
        sh[0] = slot; }
    __syncthreads(); const int r = sh[0]; __syncthreads(); return r;
}
constexpr int A_SPLITS = 4, B_SPLITS = 8;
__device__ __forceinline__ float lam_of(const Frame& F, int j, float lam_init) { const float* lp = F.a->in[13] + j * 256; float l0 = 0.f, l1 = 0.f;
    for (int i = 0; i < 64; ++i) { l0 += lp[i] * lp[64 + i]; l1 += lp[128 + i] * lp[192 + i]; } return __expf(l0) - __expf(l1) + lam_init; }
#ifndef MK_DUPSEL
#define MK_DUPSEL 0
#endif
__device__ __forceinline__ void p_attn_a(Frame& F, int j, float lam_init, int rep = 0) {
    const float lam = lam_of(F, j, lam_init); const int slot0 = attn_slot(F, j ? 2 : 0);
    const int cv = j;
    for (int slot = slot0; slot < 256; slot += F.G) {
        const int spos = cv ? (slot >> 3) % 5 : (((slot >> 7) & 1) ? 4 : 0);
        for (int it = 0; it < 5; ++it) { const int is = it == spos ? 0 : 2 + (it < spos ? it : it - 1);
            AttnUnit u; u.cv = cv; u.dual = 0; u.head2 = 0;
            if (is < 2) {
                const int bp = slot >> 2, sp = slot & 3; u.samp = 1; u.dual = 1; u.b = bp >> 3; u.head = 2 * (bp & 7); u.head2 = u.head + 1; u.qb = 0; u.qrow0 = NP + u.b * TS; u.t0 = 16 * sp; u.ntiles = sp == 3 ? 65 : 16 * sp + 16; u.split = sp; }
            else { const int r = is - 2, x = slot & 7, i = slot >> 3, k = i & 15, bh = x * 8 + 2 * r + (i >> 4);
                u.samp = 0; u.b = bh >> 4; u.head = bh & 15; u.qb = (r & 1) ? 15 - k : k; u.qrow0 = u.b * TP + u.qb * 128; u.ntiles = 2 * u.qb + 2; u.t0 = 0; u.split = -1; }
            if (u.samp && !cv) attn_unit<0, false>(F, u, j, lam, lam_init, 0); else attn_unit<0, true>(F, u, j, lam, lam_init, 0); }
    }
}
__device__ __forceinline__ void p_attn_b(Frame& F) {
    const int slot0 = attn_slot(F, 1);
    for (int slot = slot0; slot < 256; slot += F.G) {
        for (int part = 0; part < 2; ++part) { const bool do_sample = ((slot >> 3) & 1) ? (part == 1) : (part == 0);
            if (do_sample) { const int bg = slot >> 3, sp = slot & 7;
                AttnUnit u; u.cv = 0; u.dual = 0; u.head2 = 0; u.samp = 1; u.b = bg >> 2; u.head = bg & 3; u.qb = 0; u.qrow0 = NP + u.b * TS; u.t0 = 8 * sp; u.ntiles = sp == 7 ? 65 : 8 * sp + 8; u.split = sp; attn_unit<1, false>(F, u, 0, 0.f, 0.f); }
            else { const int x = slot & 7, i = slot >> 3;
                for (int r = 0; r < 2; ++r) { const int bg = 2 * x + r;
                    AttnUnit u; u.cv = 0; u.dual = 0; u.head2 = 0; u.samp = 0; u.b = bg >> 2; u.head = bg & 3; u.qb = r ? 31 - i : i; u.qrow0 = u.b * TP + u.qb * 64; u.ntiles = u.qb + 1; u.t0 = 0; u.split = -1; attn_unit<1, true>(F, u, 0, 0.f, 0.f); } }
        }
    }
}
template <int LAYER>
__device__ __forceinline__ void p_attn_combine(Frame& F, int j, float lam_init) {
    constexpr int NSPL = LAYER == 0 ? A_SPLITS : B_SPLITS;
    const float lam = LAYER == 0 ? lam_of(F, j, lam_init) : 0.f;
    const int gw = F.bid * NWAVES + F.wave, NGW = F.G * NWAVES, lane = F.lane;
    const float* PA = (const float*)(F.ws + WS_APART); bf16* OB = (bf16*)(F.ws + WS_OB);
    for (int it = gw; it < NS * 16; it += NGW) { const int r = it >> 4, h = it & 15, row = NP + r;
        f32x2 acc[2]; float lsum[2];
#pragma unroll
        for (int mp = 0; mp < (LAYER == 0 ? 2 : 1); ++mp) { const int hd = LAYER == 0 ? h * 2 + mp : h;
            float mm[NSPL], ll[NSPL]; f32x2 oo[NSPL]; float mx = -1e30f;
#pragma unroll
            for (int s = 0; s < NSPL; ++s) { const float* pr = PA + (((size_t)s * NS + r) * 32 + hd) * 130; oo[s] = *(const GAS f32x2*)(pr + 2 * lane); mm[s] = pr[128]; ll[s] = pr[129]; mx = fmaxf(mx, mm[s]); }
            f32x2 a = {0.f, 0.f}; float l = 0.f;
#pragma unroll
            for (int s = 0; s < NSPL; ++s) { const float f = __builtin_amdgcn_exp2f(mm[s] - mx); a = a + oo[s] * f; l += ll[s] * f; }
            acc[mp] = a; lsum[mp] = l; }
        f32x2 o;
        if (LAYER == 0) { o = acc[0] * __builtin_amdgcn_rcpf(lsum[0]) - acc[1] * (lam * __builtin_amdgcn_rcpf(lsum[1]));
            const float ss = wave_sum(o.x * o.x + o.y * o.y); const float rsn = rsqrtf(ss * (1.f / 128.f) + 1e-5f) * (1.f - lam_init);
            const f32x2 sg = *(const GAS f32x2*)(F.a->in[14] + j * 128 + 2 * lane); o = o * rsn * sg; }
        else o = acc[0] * __builtin_amdgcn_rcpf(lsum[0]);
        const unsigned gg = *(const GAS unsigned*)((const bf16*)(F.ws + (LAYER == 0 ? WS_GA : WS_GB)) + (size_t)row * D + h * 128 + 2 * lane);
        *(GAS unsigned*)(OB + (size_t)row * D + h * 128 + 2 * lane) = cvtpk(o.x * bf_lo(gg), o.y * bf_hi(gg)); }
}
constexpr int QISTR = 2064;
template <int CTRL> __device__ __forceinline__ int dppi(int x) { return __builtin_amdgcn_update_dpp(0, x, CTRL, 0xF, 0xF, true); }
__device__ __forceinline__ int wave_isum(int v) {
    v += dppi<0xB1>(v); v += dppi<0x4E>(v); v += dppi<0x141>(v); v += dppi<0x140>(v);
    return __builtin_amdgcn_readlane(v, 0) + __builtin_amdgcn_readlane(v, 16) + __builtin_amdgcn_readlane(v, 32) + __builtin_amdgcn_readlane(v, 48);
}
__device__ __forceinline__ unsigned tokey(float x) { x += 0.f; const unsigned u = __builtin_bit_cast(unsigned, x); return (u & 0x80000000u) ? ~u : (u | 0x80000000u); }
template <int NREG>
__device__ __forceinline__ void select_row(const float* sc, int nadm, unsigned* mrow, int lane) {
    unsigned key[NREG];
#pragma unroll
    for (int i = 0; i < NREG; ++i) { const int s = 64 * i + lane; key[i] = s < nadm ? tokey(__builtin_bit_cast(float, __hip_atomic_load((const unsigned*)sc + s, __ATOMIC_RELAXED, __HIP_MEMORY_SCOPE_AGENT))) : 0u; }
    unsigned T = 0u;
    for (int bit = 31; bit >= 0; --bit) { const unsigned cand = T | (1u << bit); int c4[4] = {0, 0, 0, 0};
#pragma unroll
        for (int i = 0; i < NREG; ++i) c4[i & 3] += key[i] >= cand ? 1 : 0;
        const int c = wave_isum((c4[0] + c4[1]) + (c4[2] + c4[3])); if (c >= 256) T = cand; }
    int cg = 0;
#pragma unroll
    for (int i = 0; i < NREG; ++i) cg += key[i] > T ? 1 : 0;
    cg = wave_isum(cg);
    const int need = 256 - cg; int run = 0; const unsigned long long lt = (1ull << lane) - 1ull;
#pragma unroll
    for (int i = 0; i < NREG; ++i) { if (64 * i < nadm) { const bool eq = key[i] == T; const unsigned long long be = __ballot(eq); const int rank = run + __popcll(be & lt);
            const bool sel = key[i] > T || (eq && rank < need); const unsigned long long bs = __ballot(sel);
            if (lane == 0) { mrow[2 * i] = (unsigned)bs; mrow[2 * i + 1] = (unsigned)(bs >> 32); } run += __popcll(be); } }
}
__device__ __forceinline__ void idx_unit(Frame& F, int samp, int b, int qb, int part = -1) {
    const int tid = F.tid, lane = F.lane, w = F.wave, r32 = lane & 31, hi = lane >> 5;
    const int row0 = samp ? NP + b * TS + 32 * qb : b * TP + 32 * qb;
    const int nadm = samp ? SALL : ((qb >> 1) + 1) * 64, nst = nadm / 32;
    LAS unsigned char* lds = F.lds; LAS float* wiT = (LAS float*)(lds + 32 * QISTR);
    const bf16* QI = (const bf16*)(F.ws + WS_QI); const bf16* KI = (const bf16*)(F.ws + WS_KI); const float* WI = (const float*)(F.ws + WS_WI);
    float* SC = (float*)(F.ws + WS_SC); const int scld = samp ? SALL : 2048; float* sc0 = samp ? SC + SC_S_OFF + (size_t)(row0 - NP) * SALL : SC + (size_t)row0 * 2048;
#pragma unroll
    for (int i = 0; i < 8; ++i) { const int p = tid + 512 * i, r = p >> 7, c = p & 127; *(LAS v4u*)(lds + r * QISTR + c * 16) = *(const GAS v4u*)(QI + (size_t)(row0 + r) * 1024 + c * 8); }
    wiT[(tid & 15) * 32 + (tid >> 4)] = WI[(size_t)(row0 + (tid >> 4)) * 16 + (tid & 15)];
    __syncthreads();
    const int st0 = part < 0 ? 0 : (part * nst) >> 2, st1 = part < 0 ? nst : ((part + 1) * nst) >> 2;
    for (int st = st0 + w; st < st1; st += NWAVES) {
        const int s = st * 32 + r32; bf16x8 kf[4];
        if (samp && s < PAST) { const float* kp = F.a->in[6] + ((size_t)b * PAST + s) * 64 + 8 * hi;
#pragma unroll
            for (int ks = 0; ks < 4; ++ks) { const v4u a = *(const GAS v4u*)(kp + 16 * ks), c = *(const GAS v4u*)(kp + 16 * ks + 4); kf[ks] = __builtin_bit_cast(bf16x8, cvt8(a, c)); } }
        else { const bf16* kp = KI + (size_t)(samp ? NP + b * TS + (s - PAST) : b * TP + s) * 64 + 8 * hi;
#pragma unroll
            for (int ks = 0; ks < 4; ++ks) kf[ks] = *(const GAS bf16x8*)(kp + 16 * ks); }
        f32x16 sc;
#pragma unroll
        for (int r = 0; r < 16; ++r) sc[r] = 0.f;
#pragma unroll 2
        for (int h = 0; h < 16; ++h) {
            f32x16 acc;
#pragma unroll
            for (int r = 0; r < 16; ++r) acc[r] = 0.f;
            const LAS unsigned char* qp = lds + r32 * QISTR + (h * 64 + 8 * hi) * 2;
#pragma unroll
            for (int ks = 0; ks < 4; ++ks) acc = __builtin_amdgcn_mfma_f32_32x32x16_bf16(*(const LAS bf16x8*)(qp + ks * 32), kf[ks], acc, 0, 0, 0);
#pragma unroll
            for (int rg = 0; rg < 4; ++rg) { const f32x4 wq = *(const LAS f32x4*)(wiT + h * 32 + 8 * rg + 4 * hi);
#pragma unroll
                for (int e = 0; e < 4; ++e) sc[4 * rg + e] += wq[e] * fmaxf(acc[4 * rg + e] * 0.125f, 0.f); }
        }
#pragma unroll
        for (int r = 0; r < 16; ++r) sc0[(size_t)crow(r, hi) * scld + s] = sc[r];
    }
    __syncthreads();
    unsigned* MASKp = (unsigned*)(F.ws + WS_MASK);
    (void)MASKp;
}
__device__ __forceinline__ void p_idx(Frame& F, int rep = 0) {
    for (int U = F.bid; U < (F.G == 256 ? 256 : 320); U += F.G) {
        if (U < 256) idx_unit(F, 0, U & 3, 63 - (U >> 2));
        else { const int v = U - 256; idx_unit(F, 1, (v >> 1) & 7, v & 1, v >> 4); }
    }
    if (F.G == 256 && F.bid >= 192) { const int v = 255 - F.bid; idx_unit(F, 1, (v >> 1) & 7, v & 1, v >> 4); }
}
__device__ __forceinline__ void p_idx_select(Frame& F) {
    const int gw = F.wave * F.G + F.bid, NGW = F.G * NWAVES, lane = F.lane;
    unsigned* MASKp = (unsigned*)(F.ws + WS_MASK); const float* SC = (const float*)(F.ws + WS_SC);
    for (int k = 0;; ++k) {
        int it;
        if (NGW == 2048) { if (gw < 512) { if (k > 4) break; it = k == 0 ? gw : NS + 6144 + 512 * (k - 1) + gw; } else { if (k > 3) break; it = NS + (gw - 512) + 1536 * k; } }
        else { it = gw + k * NGW; if (it >= M) break; }
        int row, nadm; const float* scr;
        if (it < NS) { row = NP + it; nadm = SALL; scr = SC + SC_S_OFF + (size_t)it * SALL; }
        else { const int q = it - NS, t = TP - 1 - (q >> 2), b = q & 3; row = b * TP + t; nadm = ((t >> 6) + 1) * 64; scr = SC + (size_t)row * 2048; }
        unsigned* mrow = MASKp + (size_t)row * MASKW;
        if (nadm <= 256) { if (lane < nadm / 32) mrow[lane] = 0xffffffffu; }
        else if (row >= NP) select_row<65>(scr, nadm, mrow, lane);
        else if (nadm <= 512) select_row<8>(scr, nadm, mrow, lane);
        else if (nadm <= 1024) select_row<16>(scr, nadm, mrow, lane);
        else if (nadm <= 1536) select_row<24>(scr, nadm, mrow, lane);
        else select_row<32>(scr, nadm, mrow, lane);
    }
}

constexpr int SC_BUF = 49152, SC_O = 98304, TC = 32;
template <int CTRL> __device__ __forceinline__ float dppf(float x) { return __builtin_bit_cast(float, __builtin_amdgcn_update_dpp(0, __builtin_bit_cast(int, x), CTRL, 0xF, 0xF, true)); }
#define DPP_X1 0xB1
#define DPP_X2 0x4E
#define DPP_HM 0x141
#define DPP_RM 0x140
__device__ __forceinline__ float red8(float v) { v += dppf<DPP_X1>(v); v += dppf<DPP_X2>(v); v += dppf<DPP_HM>(v); return v; }
__device__ __forceinline__ float red16(float v) { v = red8(v); v += dppf<DPP_RM>(v); return v; }
struct ScanRaw { f32x4 r, k, v, g, d, a; };
#ifndef MK_EXPC
#define MK_EXPC 0
#endif
__device__ __forceinline__ void scan_unit(Frame& F, int samp, int b, int h, int xmode = 0) {
    const int tid = F.tid, vp = (tid >> 3) & 31, kq = tid & 7, srow = tid >> 4, c4 = tid & 15;
    const int T = samp ? TS : TP, row0 = samp ? NP + b * TS : b * TP, nch = T / TC;
    LAS unsigned char* lds = F.lds;
    const float* Rg = (const float*)(F.ws + WS_R); const float* Kg = (const float*)(F.ws + WS_K); const float* Vg = (const float*)(F.ws + WS_V); const float* Gg = (const float*)(F.ws + WS_G);
    const float* Dg = (const float*)(F.ws + WS_DEC); const float* Ag = (const float*)(F.ws + WS_AS); bf16* OB = (bf16*)(F.ws + WS_OB);
    const int hc = h * 64 + 4 * c4;
    const f32x4 kk_w = *(const GAS f32x4*)(F.a->in[24] + hc), ka_w = *(const GAS f32x4*)(F.a->in[25] + hc), rk_w = *(const GAS f32x4*)(F.a->in[26] + hc), lnw = *(const GAS f32x4*)(F.a->in[27] + hc), lnb = *(const GAS f32x4*)(F.a->in[28] + hc);
    const bool scanner = F.wave < 4;
    f32x2 S[8];
    { const float* sp = F.a->in[7] + (((size_t)b * 32 + h) * 64 + 2 * vp) * 64 + 8 * kq; f32x4 a0 = {0.f, 0.f, 0.f, 0.f}, a1 = a0, c0 = a0, c1 = a0;
      if (samp && scanner) { a0 = *(const GAS f32x4*)sp; a1 = *(const GAS f32x4*)(sp + 4); c0 = *(const GAS f32x4*)(sp + 64); c1 = *(const GAS f32x4*)(sp + 68); }
#pragma unroll
      for (int i = 0; i < 4; ++i) { S[i] = (f32x2){a0[i], c0[i]}; S[4 + i] = (f32x2){a1[i], c1[i]}; } }
    ScanRaw raw; f32x4 cv, cg; float cbd;
#define SCAN_LOAD(ch) do { const size_t o_ = (size_t)(row0 + (ch) * TC + srow) * D + hc; raw.r = *(const GAS f32x4*)(Rg + o_); raw.k = *(const GAS f32x4*)(Kg + o_); raw.v = *(const GAS f32x4*)(Vg + o_); \
        raw.g = *(const GAS f32x4*)(Gg + o_); raw.d = *(const GAS f32x4*)(Dg + o_); raw.a = *(const GAS f32x4*)(Ag + o_); } while (0)
#define SCAN_STAGE(bi) do { LAS unsigned char* bp_ = lds + (bi) * SC_BUF + (srow * 64 + 4 * c4) * 4; \
        const f32x4 kkr_ = raw.k * kk_w; const float ss_ = red16((kkr_[0] * kkr_[0] + kkr_[1] * kkr_[1]) + (kkr_[2] * kkr_[2] + kkr_[3] * kkr_[3])); \
        const f32x4 kkn_ = kkr_ * (1.f / fmaxf(sqrtf(ss_), 1e-12f)); const f32x4 km_ = raw.k * (1.f + (raw.a - 1.f) * ka_w); const f32x4 rkr_ = raw.r * km_ * rk_w; \
        cbd = red16((rkr_[0] + rkr_[1]) + (rkr_[2] + rkr_[3])); cv = raw.v; cg = raw.g; \
        *(LAS f32x4*)(bp_) = raw.r; *(LAS f32x4*)(bp_ + 8192) = raw.d; *(LAS f32x4*)(bp_ + 16384) = km_; *(LAS f32x4*)(bp_ + 24576) = kkn_; *(LAS f32x4*)(bp_ + 32768) = kkn_ * raw.a; *(LAS f32x4*)(bp_ + 40960) = raw.v; } while (0)
    SCAN_LOAD(0); SCAN_STAGE(0);
    __syncthreads();
    LAS float* sO = (LAS float*)(lds + SC_O);
    for (int ch = 0; ch < nch; ++ch) {
        const bool more = ch + 1 < nch;
        const f32x4 ev = cv, eg = cg; const float ebd = cbd;
        if (more) SCAN_LOAD(ch + 1);
        if (scanner && !(xmode & 1)) {
            const LAS unsigned char* bp = lds + (ch & 1) * SC_BUF + kq * 32;
            const LAS unsigned char* vvp = lds + (ch & 1) * SC_BUF + 40960 + 8 * vp;
            struct StepV { f32x4 rr[2], ww[2], kx[2], qq[2], bb[2]; f32x2 vv; };
#define SCAN_FETCH(dst, t) do { const LAS unsigned char* tp_ = bp + (t) * 256; _Pragma("unroll") for (int hh = 0; hh < 2; ++hh) { dst.rr[hh] = *(const LAS f32x4*)(tp_ + 16 * hh); dst.ww[hh] = *(const LAS f32x4*)(tp_ + 8192 + 16 * hh); \
                dst.kx[hh] = *(const LAS f32x4*)(tp_ + 16384 + 16 * hh); dst.qq[hh] = *(const LAS f32x4*)(tp_ + 24576 + 16 * hh); dst.bb[hh] = *(const LAS f32x4*)(tp_ + 32768 + 16 * hh); } \
                dst.vv = *(const LAS f32x2*)(vvp + (t) * 256); } while (0)
            StepV cur; SCAN_FETCH(cur, 0);
            for (int t8 = 0; t8 < TC; t8 += 8) {
                f32x2 keep = {0.f, 0.f};
#pragma unroll
                for (int j = 0; j < 8; ++j) {
                    StepV nxt; { const int tn = (t8 + j + 1 < TC) ? t8 + j + 1 : t8 + j; SCAN_FETCH(nxt, tn); }
                    asm volatile("" ::: "memory");
                    f32x2 sa0 = S[0] * cur.qq[0][0] + S[1] * cur.qq[0][1], sa1 = S[2] * cur.qq[0][2] + S[3] * cur.qq[0][3], sa2 = S[4] * cur.qq[1][0] + S[5] * cur.qq[1][1], sa3 = S[6] * cur.qq[1][2] + S[7] * cur.qq[1][3];
                    f32x2 tt[8];
#pragma unroll
                    for (int i = 0; i < 8; ++i) tt[i] = S[i] * cur.ww[i >> 2][i & 3] + cur.vv * cur.kx[i >> 2][i & 3];
                    f32x2 sa = (sa0 + sa1) + (sa2 + sa3);
                    { float sx = sa.x, sy = sa.y; asm volatile("" : "+v"(sx)); asm volatile("" : "+v"(sy)); sx = red8(sx); asm volatile("" : "+v"(sx)); sy = red8(sy); sa.x = -sx; sa.y = -sy; }
#pragma unroll
                    for (int i = 0; i < 8; ++i) S[i] = tt[i] + sa * cur.bb[i >> 2][i & 3];
                    f32x2 oo = ((S[0] * cur.rr[0][0] + S[1] * cur.rr[0][1]) + (S[2] * cur.rr[0][2] + S[3] * cur.rr[0][3])) + ((S[4] * cur.rr[1][0] + S[5] * cur.rr[1][1]) + (S[6] * cur.rr[1][2] + S[7] * cur.rr[1][3]));
                    { float ox = oo.x, oy = oo.y; asm volatile("" : "+v"(ox)); asm volatile("" : "+v"(oy)); ox = red8(ox); asm volatile("" : "+v"(ox)); oy = red8(oy); oo.x = ox; oo.y = oy; }
                    if (kq == j) keep = oo;
                    cur = nxt;
                }
                *(LAS f32x2*)(sO + (t8 + kq) * 64 + 2 * vp) = keep;
            }
#undef SCAN_FETCH
        }
        __syncthreads();
        { const f32x4 o4 = *(const LAS f32x4*)(sO + srow * 64 + 4 * c4);
          const float mean = red16((o4[0] + o4[1]) + (o4[2] + o4[3])) * (1.f / 64.f); const f32x4 dl = o4 - mean;
          const float var = red16((dl[0] * dl[0] + dl[1] * dl[1]) + (dl[2] * dl[2] + dl[3] * dl[3])) * (1.f / 64.f); const float rstd = rsqrtf(var + 64e-5f);
          f32x4 y = dl * rstd * lnw + lnb + ev * ebd; y = (f32x4){y[0] * silu_f(eg[0]), y[1] * silu_f(eg[1]), y[2] * silu_f(eg[2]), y[3] * silu_f(eg[3])};
          v2u wv; wv.x = cvtpk(y[0], y[1]); wv.y = cvtpk(y[2], y[3]); *(GAS v2u*)(OB + (size_t)(row0 + ch * TC + srow) * D + hc) = wv; }
        if (more) SCAN_STAGE((ch + 1) & 1);
        __syncthreads();
    }
#undef SCAN_LOAD
#undef SCAN_STAGE
    if (scanner) { float* so = F.out + (samp ? O_CWS : O_CWP) + (((size_t)b * 32 + h) * 64 + 2 * vp) * 64 + 8 * kq;
      *(GAS f32x4*)so = (f32x4){S[0].x, S[1].x, S[2].x, S[3].x}; *(GAS f32x4*)(so + 4) = (f32x4){S[4].x, S[5].x, S[6].x, S[7].x};
      *(GAS f32x4*)(so + 64) = (f32x4){S[0].y, S[1].y, S[2].y, S[3].y}; *(GAS f32x4*)(so + 68) = (f32x4){S[4].y, S[5].y, S[6].y, S[7].y}; }
}
__device__ __forceinline__ void cache_conv(Frame& F, int rank, int nwg) {
    constexpr unsigned NV8 = 8u * PAST * D / 8u;
    int tid = F.tid; asm volatile("" : "+v"(tid));
    const unsigned stride = (unsigned)nwg * NTHR;
    for (int which = 0; which < 2; ++which) {
        const char* src = (const char*)(F.a->in[2 + which] + (size_t)8 * PAST * D); unsigned char* dst = F.ws + (which ? WS_VC : WS_KC);
        for (unsigned i = (unsigned)rank * NTHR + tid; i < NV8; i += 4u * stride) {
            v4u a[4][2];
#pragma unroll
            for (int q = 0; q < 4; ++q) { const unsigned idx = i + q * stride; if (idx < NV8) { a[q][0] = gld<v4u>(src, idx * 32u); a[q][1] = gld<v4u>(src, idx * 32u + 16u); } }
#pragma unroll
            for (int q = 0; q < 4; ++q) { const unsigned idx = i + q * stride; if (idx < NV8) *(GAS v4u*)((GAS unsigned char*)dst + idx * 16u) = cvt8(a[q][0], a[q][1]); }
        }
    }
}
__device__ __forceinline__ void p_scan(Frame& F, int rep = 0) {
    const int xm = (MK_EXPC && rep == 0) ? MK_EXPC : 0;
    for (int slot = F.bid; slot < 256; slot += F.G) {
        if (slot < 128) scan_unit(F, 0, slot >> 5, slot & 31, xm);
        else { const int su = slot - 128; scan_unit(F, 1, su >> 5, su & 31); scan_unit(F, 1, (su + 128) >> 5, (su + 128) & 31);
            __syncthreads(); conv_deferred(F, su, 128); if (!(MK_EXPC & 2) || rep == 1) cache_conv(F, su, 128); }
    }
}
constexpr int NPHASES = 23;

template <class Epi, class Sched>
__device__ __forceinline__ void run_gemm(Frame& F, const bf16* A, const bf16* Bt, int Mm, int Nn, int Kk, const Sched& S, const Epi& E) {
    pg8::Gemm g{A, Bt, Mm, Nn, Kk, Kk};
    pg8::gemm_phase<Epi, Sched, true, true>(F.lds, g, S, E);
}

__global__ void __launch_bounds__(NTHR, 2) mega(Args args) {
    extern __shared__ __attribute__((aligned(16))) unsigned char lds_raw[];
    Frame F;
    F.lds = (LAS unsigned char*)lds_raw;
    F.tid = threadIdx.x; F.lane = F.tid & 63; F.wave = __builtin_amdgcn_readfirstlane(F.tid >> 6); F.G = gridDim.x; F.bid = blockIdx.x;
    F.a = (const __attribute__((address_space(4))) Args*)__builtin_amdgcn_kernarg_segment_ptr(); F.out = args.out; F.ws = args.ws;
    volatile LAS unsigned* MISC = (volatile LAS unsigned*)(F.lds + MISC_OFF);
    for (int u = F.tid; u < (LDS_BYTES - RING_BYTES) / 4; u += NTHR) ((LAS unsigned*)(F.lds + RING_BYTES))[u] = 0u;
    __syncthreads();
    unsigned* ctl = (unsigned*)(F.ws + WS_CTL);
    const int lo = args.ph_lo, hi = args.ph_hi;
    XcdBarrier bar; bar.bar = ctl + CW_BAR + args.li * XCD_BAR_WORDS; bar.x = 0; bar.st = nullptr;
    if (hi - lo > 1) bar = xcd_barrier_post(ctl + CW_BAR + args.li * XCD_BAR_WORDS, MISC + 8);
    F.census = (hi - lo > 1 && lo == 0) ? ctl + CW_BAR + args.li * XCD_BAR_WORDS : nullptr;
#ifndef PH_MASK
#define PH_MASK 0x7fffff
#endif
#define IN(k) ((((PH_MASK) >> (k)) & 1) && lo <= (k) && (k) < hi)
#ifndef MK_DUP
#define MK_DUP 0
#endif
#define REP(k) for (int rep_ = 0; rep_ < 1 + (((MK_DUP) >> (k)) & 1); ++rep_)
#define SEAM(k) do { if (IN(k) && IN((k) + 1)) xcd_barrier(bar); } while (0)
    unsigned char* ws = F.ws;
    float* XS0 = (float*)(ws + WS_XS); float* XS1 = XS0 + (size_t)NS * D;
    bf16* HB = (bf16*)(ws + WS_HB); bf16* OB = (bf16*)(ws + WS_OB); float* XR = (float*)(ws + WS_XRES);
    const bf16* WA = (const bf16*)(ws + WS_WA); const bf16* WB = (const bf16*)(ws + WS_WB); const bf16* WC1 = (const bf16*)(ws + WS_WC1); const bf16* WC2 = (const bf16*)(ws + WS_WC2); const bf16* WO = (const bf16*)(ws + WS_WO);
    const float* tab64 = (const float*)(ws + WS_TAB64); const float* tab128 = (const float*)(ws + WS_TAB128);

    if (IN(0)) REP(0) p0_prologue(F);
    SEAM(0);
    if (IN(1)) REP(1) { pg8::StaticOrder S; S.init(M, 8192, F.G, F.bid);
        pg8::EpiAIn E{(bf16*)(ws + WS_QA), (bf16*)(ws + WS_KA), (bf16*)(ws + WS_VA), (bf16*)(ws + WS_GA), F.out + O_AKP, F.out + O_AKS, F.out + O_AVP, F.out + O_AVS, tab64, QSCALE_A};
        run_gemm(F, HB, WA, M, 8192, D, S, E);
        if (rep_ == 0) { const int nfull = (1088 + F.G - 1) / F.G, nlong = 1088 - (nfull - 1) * F.G;
            if (F.bid >= nlong) { __syncthreads(); conv_deferred2(F, F.bid - nlong, F.G - nlong); } else if (nlong >= F.G) { __syncthreads(); conv_deferred2(F, F.bid, F.G); } } }
    SEAM(1);
    if (IN(2)) REP(2) p_attn_a(F, 0, 0.2f, rep_);
    SEAM(2);
    if (IN(3)) REP(3) p_attn_combine<0>(F, 0, 0.2f);
    SEAM(3);
    if (IN(4)) REP(4) { pg8::OutOrder S; S.init(F.G, F.bid); pg8::EpiOut E{F.a->in[0], XR, (float*)(ws + WS_PART)}; run_gemm(F, OB, WO, M, D, D, S, E); }
    SEAM(4);
    if (IN(5)) REP(5) p_norm(F, XR, F.a->in[1], F.a->in[9] + 1 * D, 0, true, XS0);
    SEAM(5);
    if (IN(6)) REP(6) { pg8::StaticOrder S; S.init(M, 6400, F.G, F.bid);
        pg8::EpiBIn E{(bf16*)(ws + WS_QB), (bf16*)(ws + WS_KB), (bf16*)(ws + WS_VB), (bf16*)(ws + WS_QI), (bf16*)(ws + WS_KI), (bf16*)(ws + WS_GB), (float*)(ws + WS_WI),
                      F.out + O_BKP, F.out + O_BKS, F.out + O_BVP, F.out + O_BVS, F.out + O_BIP, F.out + O_BIS, tab64, tab128, QSCALE_B};
        run_gemm(F, HB, WB, M, 6400, D, S, E); }
    SEAM(6);
    if (IN(7)) REP(7) p_idx(F, rep_);
    SEAM(7);
    if (IN(8)) REP(8) p_idx_select(F);
    SEAM(8);
    if (IN(9)) REP(9) p_attn_b(F);
    SEAM(9);
    if (IN(10)) REP(10) p_attn_combine<1>(F, 0, 0.f);
    SEAM(10);
    if (IN(11)) REP(11) { pg8::OutOrder S; S.init(F.G, F.bid); pg8::EpiOut E{XR, XR, (float*)(ws + WS_PART)}; run_gemm(F, OB, WO + (size_t)1 * D * D, M, D, D, S, E); }
    SEAM(11);
    if (IN(12)) REP(12) p_norm_lerp(F, XR, XS0, F.a->in[9] + 2 * D, XS1);
    SEAM(12);
    if (IN(13)) REP(13) { pg8::COrder S{F.G, F.bid}; pg8::EpiC1 E{(float*)(ws + WS_R), (bf16*)(ws + WS_XL), (size_t)M * D}; run_gemm(F, (const bf16*)(ws + WS_L6), WC1, 6 * M, 34 * 256, D, S, E); }
    SEAM(13);
    if (IN(14)) REP(14) { pg8::StaticOrder S; S.init(M, 4096, F.G, F.bid); pg8::EpiC2 E{(float*)(ws + WS_DEC), (float*)(ws + WS_AS), F.a->in[18], F.a->in[21]}; run_gemm(F, (const bf16*)(ws + WS_XL), WC2, M, 4096, 256, S, E); }
    SEAM(14);
    if (IN(15)) REP(15) p_scan(F, rep_);
    SEAM(15);
    if (IN(16)) REP(16) { pg8::OutOrder S; S.init(F.G, F.bid); pg8::EpiOut E{XR, XR, (float*)(ws + WS_PART)}; run_gemm(F, OB, WO + (size_t)2 * D * D, M, D, D, S, E); }
    SEAM(16);
    if (IN(17)) REP(17) p_norm(F, XR, XS1, F.a->in[9] + 3 * D, 0, true, XS0);
    SEAM(17);
    if (IN(18)) REP(18) { pg8::StaticOrder S; S.init(M, 8192, F.G, F.bid);
        pg8::EpiAIn E{(bf16*)(ws + WS_QA), (bf16*)(ws + WS_KA), (bf16*)(ws + WS_VA), (bf16*)(ws + WS_GA), F.out + O_AKP + (size_t)NP * D, F.out + O_AKS + (size_t)NS * D, F.out + O_AVP + (size_t)NP * D, F.out + O_AVS + (size_t)NS * D, tab64, QSCALE_A};
        run_gemm(F, HB, WA + (size_t)8192 * D, M, 8192, D, S, E); }
    SEAM(18);
    if (IN(19)) REP(19) p_attn_a(F, 1, 0.8f - 0.6f * 0.40656965974059911f, rep_);
    SEAM(19);
    if (IN(20)) REP(20) p_attn_combine<0>(F, 1, 0.8f - 0.6f * 0.40656965974059911f);
    SEAM(20);
    if (IN(21)) REP(21) { pg8::OutOrder S; S.init(F.G, F.bid); pg8::EpiOut E{XR, XR, (float*)(ws + WS_PART)}; run_gemm(F, OB, WO + (size_t)3 * D * D, M, D, D, S, E); }
    SEAM(21);
    if (IN(22)) REP(22) p_norm(F, XR, XS0, F.a->in[10], 2, true, XS1);
#undef IN
#undef SEAM
}

#ifndef MK_CUTS
#define MK_CUTS 1
#endif
static int mk_setup() {
    static int grid = 0;
    if (grid == 0) {
        int dev = 0, cus = 0, per_cu = 0;
        if (hipGetDevice(&dev) != hipSuccess || hipDeviceGetAttribute(&cus, hipDeviceAttributeMultiprocessorCount, dev) != hipSuccess) { fprintf(stderr, "kernel_launch: device query failed\n"); grid = -1; return grid; }
        if (hipFuncSetAttribute((const void*)mega, hipFuncAttributeMaxDynamicSharedMemorySize, LDS_BYTES) != hipSuccess) { fprintf(stderr, "kernel_launch: hipFuncSetAttribute failed\n"); grid = -1; return grid; }
        if (hipOccupancyMaxActiveBlocksPerMultiprocessor(&per_cu, (const void*)mega, NTHR, LDS_BYTES) != hipSuccess || per_cu < 1) fprintf(stderr, "kernel_launch: occupancy query reports %d\n", per_cu);
        (void)hipGetLastError();
        grid = cus;
    }
    return grid;
}
static void mk_launch(void* const* d_in, float* d_out, void* d_ws, hipStream_t stream, int ncuts, const int* cuts) {
    const int grid = mk_setup(); if (grid <= 0) return;
    (void)hipMemsetAsync((char*)d_ws + WS_CTL, 0, CTL_ZERO_BYTES, stream);
    Args a{};
    for (int i = 0; i < 29; ++i) a.in[i] = (const float*)d_in[i];
    a.out = d_out; a.ws = (unsigned char*)d_ws;
    for (int li = 0; li < ncuts; ++li) { a.ph_lo = cuts[li]; a.ph_hi = cuts[li + 1]; a.li = li; a.pad = 0;
        hipLaunchKernelGGL(mega, dim3(grid), dim3(NTHR), LDS_BYTES, stream, a);
        const hipError_t le = hipPeekAtLastError(); if (le != hipSuccess) { fprintf(stderr, "kernel_launch: launch %d failed: %s\n", li, hipGetErrorName(le)); break; } }
}
extern "C" void kernel_launch(void* const* d_in, const int* in_sizes, int n_in, void* d_out, int out_size, void* d_ws, size_t ws_size, hipStream_t stream) {
    if (n_in != 29 || (size_t)out_size != O_TOTAL || ws_size < WS_END) { fprintf(stderr, "kernel_launch: unexpected shapes n_in %d out %d ws %zu (need %zu)\n", n_in, out_size, ws_size, (size_t)WS_END); return; }
#if MK_CUTS == 1
    const int cuts[2] = {0, NPHASES}; mk_launch(d_in, (float*)d_out, d_ws, stream, 1, cuts);
#else
    int cuts[NPHASES + 1]; for (int i = 0; i <= NPHASES; ++i) cuts[i] = i; mk_launch(d_in, (float*)d_out, d_ws, stream, NPHASES, cuts);
#endif
}
```
